# Optimizing an MI355X kernel written in HIP

```python
import jax, jax.numpy as jnp
from jax import lax
import numpy as np

D_MODEL = 1024
BATCH = 4
SEQ = 4096
DEPTH = 2

GRID_W = 64
CTX_LEN = 256
HEAD_DIM = 64
Q_BLOCK = 128
WINDOW = 128
ROPE_THETA = 10000.0
RMS_EPS = 1e-6
GN_EPS = 64e-5
N_EVEN = (DEPTH + 1) // 2
N_ODD = DEPTH // 2
A_HEADS = D_MODEL // (2 * HEAD_DIM)
A_KV_HEADS = A_HEADS // 4
B_HEADS = D_MODEL // (2 * HEAD_DIM)
B_LORA = 64
A_WIDTH = A_HEADS * HEAD_DIM
A_KV_WIDTH = A_KV_HEADS * HEAD_DIM
B_WIDTH = B_HEADS * HEAD_DIM
B_PROJ = 3 * B_WIDTH + 4 * B_LORA
EVEN_IN = A_WIDTH + 2 * A_KV_WIDTH + B_PROJ + A_WIDTH + B_WIDTH
EVEN_MIX = A_WIDTH + B_WIDTH
C_HEADS = D_MODEL // HEAD_DIM
C_KV_HEADS = C_HEADS // 4
C_WIDTH = C_HEADS * HEAD_DIM
C_KV_WIDTH = C_KV_HEADS * HEAD_DIM
ODD_IN = C_WIDTH + 2 * C_KV_WIDTH + C_WIDTH

kernel_name = 'hybrid_dit_gqa_rwkv7_swa_prefix'


def _rms(x, gain):
    xf = x.astype(jnp.float32)
    xf = xf * lax.rsqrt(jnp.mean(xf * xf, axis=-1, keepdims=True) + RMS_EPS)
    return xf.astype(x.dtype) * gain


def _heads(x, n):
    return x.reshape(x.shape[:-1] + (n, HEAD_DIM))


def _axial_rope(n_tokens, dtype):
    n_rows = n_tokens // GRID_W
    t = jnp.arange(n_rows * GRID_W)
    row = (t // GRID_W).astype(jnp.float32)
    col = (t % GRID_W).astype(jnp.float32)
    axis_dim = HEAD_DIM // 2
    inv = ROPE_THETA ** (-jnp.arange(0, axis_dim, 2, dtype=jnp.float32) / axis_dim)
    ang = jnp.concatenate([row[:, None] * inv, col[:, None] * inv], axis=-1)
    return jnp.cos(ang).astype(dtype), jnp.sin(ang).astype(dtype)


def _rope(x, cos, sin):
    x1, x2 = x[..., 0::2], x[..., 1::2]
    c, s = cos[None, :, None, :], sin[None, :, None, :]
    return jnp.stack([x1 * c - x2 * s, x1 * s + x2 * c], axis=-1).reshape(x.shape)


def _dense_attention(q, k, v):
    B, T, Hq, D = q.shape
    G = k.shape[2]
    R = Hq // G
    nb = T // Q_BLOCK
    scale = HEAD_DIM ** -0.5
    qb = jnp.moveaxis(q.reshape(B, nb, Q_BLOCK, G, R, D), 1, 0)

    def block(qi):
        s = jnp.einsum('bqgrd,bsgd->bgrqs', qi, k).astype(jnp.float32) * scale
        p = jax.nn.softmax(s, axis=-1).astype(v.dtype)
        return jnp.einsum('bgrqs,bsgd->bqgrd', p, v)

    o = lax.map(block, qb)
    return jnp.moveaxis(o, 0, 1).reshape(B, T, Hq * D)


def _window_attention(q, k, v, kc, vc, sink):
    B, T, Hq, D = q.shape
    G = k.shape[2]
    R = Hq // G
    L = kc.shape[1]
    nb = T // Q_BLOCK
    band = 3 * Q_BLOCK
    scale = HEAD_DIM ** -0.5
    pad = ((0, 0), (Q_BLOCK, Q_BLOCK), (0, 0), (0, 0))
    kp, vp = jnp.pad(k, pad), jnp.pad(v, pad)
    sink_b = jnp.broadcast_to(sink.reshape(G, R, 1, 1).astype(jnp.float32), (B, G, R, Q_BLOCK, 1))

    def block(i):
        start = i * Q_BLOCK
        qi = lax.dynamic_slice_in_dim(q, start, Q_BLOCK, axis=1).reshape(B, Q_BLOCK, G, R, D)
        ki = lax.dynamic_slice_in_dim(kp, start, band, axis=1)
        vi = lax.dynamic_slice_in_dim(vp, start, band, axis=1)
        qpos = start + jnp.arange(Q_BLOCK)
        kpos = start - Q_BLOCK + jnp.arange(band)
        mask = (kpos[None, :] >= 0) & (kpos[None, :] < T) & (jnp.abs(kpos[None, :] - qpos[:, None]) <= WINDOW)
        s_loc = jnp.einsum('bqgrd,bkgd->bgrqk', qi, ki).astype(jnp.float32) * scale
        s_loc = jnp.where(mask, s_loc, -jnp.inf)
        s_ctx = jnp.einsum('bqgrd,bmgd->bgrqm', qi, kc).astype(jnp.float32) * scale
        p = jax.nn.softmax(jnp.concatenate([s_loc, s_ctx, sink_b], axis=-1), axis=-1).astype(v.dtype)
        return (jnp.einsum('bgrqk,bkgd->bqgrd', p[..., :band], vi)
                + jnp.einsum('bgrqm,bmgd->bqgrd', p[..., band:band + L], vc))

    o = lax.map(block, jnp.arange(nb))
    return jnp.moveaxis(o, 0, 1).reshape(B, T, Hq * D)


def _context_attention(q, k, v, sink):
    B, L, Hq, D = q.shape
    G = k.shape[2]
    R = Hq // G
    scale = HEAD_DIM ** -0.5
    s = jnp.einsum('blgrd,bmgd->bgrlm', q.reshape(B, L, G, R, D), k).astype(jnp.float32) * scale
    if sink is not None:
        s = jnp.concatenate([s, jnp.broadcast_to(sink.reshape(G, R, 1, 1).astype(jnp.float32), (B, G, R, L, 1))], axis=-1)
    p = jax.nn.softmax(s, axis=-1)[..., :L].astype(v.dtype)
    return jnp.einsum('bgrlm,bmgd->blgrd', p, v).reshape(B, L, Hq * D)


def _rwkv_streams(p, mu, w0, w2, a0, a2, k_k, k_a):
    B, T = p.shape[:2]
    pp = jnp.pad(p, ((0, 0), (1, 1), (0, 0)))
    p = p + mu * (0.5 * (pp[:, :-2] + pp[:, 2:]) - p)
    r, k, v, zw, za = jnp.split(p, [B_WIDTH, 2 * B_WIDTH, 3 * B_WIDTH, 3 * B_WIDTH + 2 * B_LORA], axis=-1)
    zw = zw.reshape(B, T, 2, B_LORA)
    za = za.reshape(B, T, 2, B_LORA)
    w_log = -jax.nn.softplus(-(w0[:, None, None, :] + jnp.einsum('btdr,drc->dbtc', jnp.tanh(zw), w2))) - 0.5
    decay = jnp.exp(-jnp.exp(w_log.astype(jnp.float32))).astype(p.dtype)
    a = _heads(jax.nn.sigmoid(a0[:, None, None, :] + jnp.einsum('btdr,drc->dbtc', za, a2)), B_HEADS)
    kkf = _heads(k * k_k, B_HEADS).astype(jnp.float32)
    kk = (kkf / jnp.maximum(jnp.sqrt(jnp.sum(kkf * kkf, axis=-1, keepdims=True)), 1e-12)).astype(p.dtype)
    kmod = _heads(k, B_HEADS)[None] * (1 + (a - 1) * _heads(k_a, B_HEADS))
    return _heads(r, B_HEADS), _heads(decay, B_HEADS), kk, kk[None] * a, kmod, _heads(v, B_HEADS)


def _rwkv_bidir_scan(r, decay, kk, b, kmod, v, state0):
    def time_major(x):
        return jnp.moveaxis(jnp.stack([x[0], jnp.flip(x[1], axis=1)], axis=0), 2, 0)

    def both(x):
        return jnp.broadcast_to(x[None], (2,) + x.shape)

    xs = (time_major(both(r)), time_major(decay), time_major(both(kk)),
          time_major(b), time_major(kmod), time_major(both(v)))

    def step(S, inp):
        r_t, w_t, kk_t, b_t, k_t, v_t = inp
        S = (S * w_t[..., None, :]
             - jnp.einsum('dbhvk,dbhk->dbhv', S, kk_t)[..., None] * b_t[..., None, :]
             + v_t[..., None] * k_t[..., None, :])
        return S, jnp.einsum('dbhvk,dbhk->dbhv', S, r_t)

    S, y = lax.scan(step, state0, xs)
    y = jnp.moveaxis(y, 0, 2)
    return jnp.stack([y[0], jnp.flip(y[1], axis=1)], axis=0), S


def _rwkv_readout(y, r, kmod, v, rk, gn_w, gn_b):
    yf = y.astype(jnp.float32)
    mean = jnp.mean(yf, axis=-1, keepdims=True)
    var = jnp.mean(jnp.square(yf - mean), axis=-1, keepdims=True)
    yn = ((yf - mean) * lax.rsqrt(var + GN_EPS)).astype(y.dtype) * gn_w + gn_b
    bonus = jnp.sum(r[None] * kmod * rk, axis=-1, keepdims=True) * v[None]
    o = jnp.sum(yn + bonus, axis=0)
    return o.reshape(o.shape[:2] + (B_WIDTH,))


def _even_mixer(hx, hc, cos, sin, need_ctx, w_in, w_out, qn, kn, mu, w0, w2, a0, a2, k_k, k_a, rk, gn_w, gn_b):
    cuts = np.cumsum([A_WIDTH, A_KV_WIDTH, A_KV_WIDTH, B_PROJ, A_WIDTH]).tolist()
    qx, kx, vx, bx, gax, gbx = jnp.split(hx @ w_in, cuts, axis=-1)
    qc, kc, vc, bc, gac, gbc = jnp.split(hc @ w_in, cuts, axis=-1)
    qx = _rope(_rms(_heads(qx, A_HEADS), qn), cos, sin)
    kx = _rope(_rms(_heads(kx, A_KV_HEADS), kn), cos, sin)
    kc = _rms(_heads(kc, A_KV_HEADS), kn)
    vx, vc = _heads(vx, A_KV_HEADS), _heads(vc, A_KV_HEADS)
    oa_x = _dense_attention(qx, jnp.concatenate([kx, kc], axis=1), jnp.concatenate([vx, vc], axis=1))
    gn_w, gn_b = gn_w.reshape(B_HEADS, HEAD_DIM), gn_b.reshape(B_HEADS, HEAD_DIM)
    r_c, d_c, kk_c, b_c, km_c, v_c = _rwkv_streams(bc, mu, w0, w2, a0, a2, k_k, k_a)
    r_x, d_x, kk_x, b_x, km_x, v_x = _rwkv_streams(bx, mu, w0, w2, a0, a2, k_k, k_a)
    state0 = jnp.zeros((2, hx.shape[0], B_HEADS, HEAD_DIM, HEAD_DIM), hx.dtype)
    y_c, state_c = _rwkv_bidir_scan(r_c, d_c, kk_c, b_c, km_c, v_c, state0)
    y_x, _ = _rwkv_bidir_scan(r_x, d_x, kk_x, b_x, km_x, v_x, state_c)
    ob_x = _rwkv_readout(y_x, r_x, km_x, v_x, rk, gn_w, gn_b)
    out_x = jnp.concatenate([oa_x * jax.nn.silu(gax), ob_x * jax.nn.silu(gbx)], axis=-1) @ w_out
    if not need_ctx:
        return out_x, None
    oa_c = _context_attention(_rms(_heads(qc, A_HEADS), qn), kc, vc, None)
    ob_c = _rwkv_readout(y_c, r_c, km_c, v_c, rk, gn_w, gn_b)
    out_c = jnp.concatenate([oa_c * jax.nn.silu(gac), ob_c * jax.nn.silu(gbc)], axis=-1) @ w_out
    return out_x, out_c


def _odd_mixer(hx, hc, cos, sin, need_ctx, w_in, w_out, qn, kn, sink):
    cuts = np.cumsum([C_WIDTH, C_KV_WIDTH, C_KV_WIDTH]).tolist()
    qx, kx, vx, gx = jnp.split(hx @ w_in, cuts, axis=-1)
    if need_ctx:
        qc, kc, vc, gc = jnp.split(hc @ w_in, cuts, axis=-1)
    else:
        kc, vc = jnp.split(hc @ w_in[:, C_WIDTH:C_WIDTH + 2 * C_KV_WIDTH], 2, axis=-1)
    qx = _rope(_rms(_heads(qx, C_HEADS), qn), cos, sin)
    kx = _rope(_rms(_heads(kx, C_KV_HEADS), kn), cos, sin)
    kc = _rms(_heads(kc, C_KV_HEADS), kn)
    vc = _heads(vc, C_KV_HEADS)
    ox = _window_attention(qx, kx, _heads(vx, C_KV_HEADS), kc, vc, sink)
    out_x = (ox * jax.nn.silu(gx)) @ w_out
    if not need_ctx:
        return out_x, None
    oc = _context_attention(_rms(_heads(qc, C_HEADS), qn), kc, vc, sink)
    return out_x, (oc * jax.nn.silu(gc)) @ w_out


def setup_inputs(seed: int = 0) -> dict:
    key = jax.random.key(seed)
    ks = jax.random.split(key, 27)
    f32 = jnp.float32
    D = D_MODEL

    def nrm(k, shape, s):
        return jax.random.normal(k, shape, f32) * s

    return {
        'x': nrm(ks[0], (BATCH, SEQ, D), 1.0),
        'c': nrm(ks[1], (BATCH, D), 1.0),
        'ctx': nrm(ks[2], (BATCH, CTX_LEN, D), 1.0),
        'c_ctx': nrm(ks[3], (D,), 1.0),
        'w_mod': nrm(ks[4], (DEPTH, D, 3 * D), 0.5 * D ** -0.5),
        'b_mod': nrm(ks[5], (DEPTH, 3 * D), 0.01),
        'g_pre': 1.0 + nrm(ks[6], (DEPTH, D), 0.05),
        'g_post': 1.0 + nrm(ks[7], (DEPTH, D), 0.05),
        'w_in_even': nrm(ks[8], (N_EVEN, D, EVEN_IN), D ** -0.5),
        'w_out_even': nrm(ks[9], (N_EVEN, EVEN_MIX, D), EVEN_MIX ** -0.5),
        'qn_a': 1.0 + nrm(ks[10], (N_EVEN, HEAD_DIM), 0.05),
        'kn_a': 1.0 + nrm(ks[11], (N_EVEN, HEAD_DIM), 0.05),
        'mu_b': jax.random.uniform(ks[12], (N_EVEN, B_PROJ), f32, 0.1, 0.9),
        'w0_b': nrm(ks[13], (N_EVEN, 2, B_WIDTH), 0.5),
        'w2_b': nrm(ks[14], (N_EVEN, 2, B_LORA, B_WIDTH), B_LORA ** -0.5),
        'a0_b': nrm(ks[15], (N_EVEN, 2, B_WIDTH), 0.5),
        'a2_b': nrm(ks[16], (N_EVEN, 2, B_LORA, B_WIDTH), B_LORA ** -0.5),
        'kk_b': 0.85 + nrm(ks[17], (N_EVEN, B_WIDTH), 0.05),
        'ka_b': 1.0 + nrm(ks[18], (N_EVEN, B_WIDTH), 0.05),
        'rk_b': nrm(ks[19], (N_EVEN, B_HEADS, HEAD_DIM), 0.1),
        'gn_w_b': 1.0 + nrm(ks[20], (N_EVEN, B_WIDTH), 0.05),
        'gn_b_b': nrm(ks[21], (N_EVEN, B_WIDTH), 0.01),
        'w_in_odd': nrm(ks[22], (N_ODD, D, ODD_IN), D ** -0.5),
        'w_out_odd': nrm(ks[23], (N_ODD, C_WIDTH, D), C_WIDTH ** -0.5),
        'qn_c': 1.0 + nrm(ks[24], (N_ODD, HEAD_DIM), 0.05),
        'kn_c': 1.0 + nrm(ks[25], (N_ODD, HEAD_DIM), 0.05),
        'sink_c': nrm(ks[26], (N_ODD, C_HEADS), 0.5),
    }


def reference(x, c, ctx, c_ctx, w_mod, b_mod, g_pre, g_post, w_in_even, w_out_even, qn_a, kn_a,
              mu_b, w0_b, w2_b, a0_b, a2_b, kk_b, ka_b, rk_b, gn_w_b, gn_b_b,
              w_in_odd, w_out_odd, qn_c, kn_c, sink_c):
    cos, sin = _axial_rope(x.shape[1], x.dtype)
    for l in range(DEPTH):
        need_ctx = l < DEPTH - 1
        mod_x = jax.nn.silu(c) @ w_mod[l] + b_mod[l]
        mod_c = jax.nn.silu(c_ctx) @ w_mod[l] + b_mod[l]
        sh_x, sc_x, gt_x = jnp.split(mod_x[:, None, :], 3, axis=-1)
        sh_c, sc_c, gt_c = jnp.split(mod_c, 3, axis=-1)
        hx = _rms(x, g_pre[l]) * (1 + sc_x) + sh_x
        hc = _rms(ctx, g_pre[l]) * (1 + sc_c) + sh_c
        if l % 2 == 0:
            i = l // 2
            yx, yc = _even_mixer(hx, hc, cos, sin, need_ctx, w_in_even[i], w_out_even[i], qn_a[i], kn_a[i],
                                 mu_b[i], w0_b[i], w2_b[i], a0_b[i], a2_b[i], kk_b[i], ka_b[i], rk_b[i],
                                 gn_w_b[i], gn_b_b[i])
        else:
            j = l // 2
            yx, yc = _odd_mixer(hx, hc, cos, sin, need_ctx, w_in_odd[j], w_out_odd[j], qn_c[j], kn_c[j], sink_c[j])
        x = x + gt_x * _rms(yx, g_post[l])
        if need_ctx:
            ctx = ctx + gt_c * _rms(yc, g_post[l])
    return x
```

```cpp
#include <hip/hip_runtime.h>
#include <hip/hip_cooperative_groups.h>
#include <cstdio>
#include <cstdint>
#include <cstring>
namespace cg = cooperative_groups;

#ifndef N_LAUNCH_MODE
#define N_LAUNCH_MODE 1
#endif

typedef __attribute__((ext_vector_type(8))) short bf16x8;
typedef __attribute__((ext_vector_type(4))) short s16x4;
typedef __attribute__((ext_vector_type(4))) float f32x4;
typedef __attribute__((ext_vector_type(2))) float f32x2;
typedef __attribute__((ext_vector_type(16))) float f32x16;
typedef __attribute__((ext_vector_type(2))) __bf16 bf16x2_t;
typedef unsigned short u16;
typedef __attribute__((ext_vector_type(4))) unsigned u32x4;
typedef __attribute__((ext_vector_type(2))) unsigned u32x2;
#define DI __device__ __forceinline__
#define MFMA32(a, b, c) __builtin_amdgcn_mfma_f32_32x32x16_bf16((a), (b), (c), 0, 0, 0)
#define MFMA16(a, b, c) __builtin_amdgcn_mfma_f32_16x16x32_bf16((a), (b), (c), 0, 0, 0)

static constexpr int TT = 4352;
static constexpr int MROWS = 4 * TT;
static constexpr int NPH = 11;

static constexpr size_t OFF_WT0 = 0;
static constexpr size_t OFF_WT1 = OFF_WT0 + 7340032;
static constexpr size_t OFF_WT2 = OFF_WT1 + 2097152;
static constexpr size_t OFF_WT3 = OFF_WT2 + 5242880;
static constexpr size_t OFF_MOD = OFF_WT3 + 2097152;
static constexpr size_t OFF_HX  = OFF_MOD + 131072;
static constexpr size_t OFF_Q   = OFF_HX + 35651584;
static constexpr size_t OFF_KB  = OFF_Q + 35651584;
static constexpr size_t OFF_VT  = OFF_KB + 8912896;
static constexpr size_t OFF_PB  = OFF_VT + 8912896;
static constexpr size_t OFF_G   = OFF_PB + 62390272;
static constexpr size_t OFF_OB  = OFF_G + 35651584;
static constexpr size_t WS_END  = OFF_OB + 35651584;
static constexpr size_t OFF_Y   = OFF_PB;

struct Params {
  const float *x, *c, *ctx, *c_ctx, *w_mod, *b_mod, *g_pre, *g_post, *w_in_even, *w_out_even, *qn_a, *kn_a,
      *mu_b, *w0_b, *w2_b, *a0_b, *a2_b, *kk_b, *ka_b, *rk_b, *gn_w_b, *gn_b_b, *w_in_odd, *w_out_odd, *qn_c, *kn_c, *sink_c;
  float* out;
  unsigned char* ws;
  int ph_lo, ph_hi;
};

DI u32x4 mk4(unsigned a, unsigned b, unsigned c, unsigned d) { u32x4 v = {a, b, c, d}; return v; }
DI u32x2 mk2(unsigned a, unsigned b) { u32x2 v = {a, b}; return v; }
DI unsigned pk2(float lo, float hi) { f32x2 v = {lo, hi}; bf16x2_t b = __builtin_convertvector(v, bf16x2_t); return __builtin_bit_cast(unsigned, b); }
DI u16 bf1(float x) { return (u16)(pk2(x, 0.f) & 0xffffu); }
DI float bf_lo(unsigned u) { return __uint_as_float(u << 16); }
DI float bf_hi(unsigned u) { return __uint_as_float(u & 0xffff0000u); }
template <int CTRL> DI float dppf(float x) { return __int_as_float(__builtin_amdgcn_update_dpp(0, __float_as_int(x), CTRL, 0xF, 0xF, true)); }
DI float reduce16(float x) { x += dppf<0xB1>(x); x += dppf<0x4E>(x); x += dppf<0x124>(x); x += dppf<0x128>(x); return x; }
DI float reduce8(float x) { x += dppf<0xB1>(x); x += dppf<0x4E>(x); x += dppf<0x141>(x); return x; }
DI float wave_sum(float x) { for (int o = 32; o >= 1; o >>= 1) x += __shfl_xor(x, o); return x; }
DI float silu(float v) { return v / (1.f + __expf(-v)); }
DI float fexp2(float x) { return __builtin_amdgcn_exp2f(x); }

DI void phase_prep(const Params& p, char* smem, int vb, int nvb) {
  const int tid = threadIdx.x;
  float* tile = (float*)smem;
  float* sc = (float*)smem;
  float* part = sc + 5120;
  for (int u = vb; u < 2048 + 384; u += nvb) {
    if (u < 2048) {
      int ti = u; const float* W; u16* Wt; int N;
      if (ti < 896) { W = p.w_in_even; Wt = (u16*)(p.ws + OFF_WT0); N = 3584; }
      else if (ti < 1152) { ti -= 896; W = p.w_out_even; Wt = (u16*)(p.ws + OFF_WT1); N = 1024; }
      else if (ti < 1792) { ti -= 1152; W = p.w_in_odd; Wt = (u16*)(p.ws + OFF_WT2); N = 2560; }
      else { ti -= 1792; W = p.w_out_odd; Wt = (u16*)(p.ws + OFF_WT3); N = 1024; }
      const int ntn = N >> 6;
      const int kt = ti / ntn, nt = ti - kt * ntn;
#pragma unroll
      for (int ps = 0; ps < 4; ++ps) {
        const int row = (tid >> 4) + 16 * ps, c4 = (tid & 15) * 4;
        const f32x4 v = *(const f32x4*)(W + (size_t)(kt * 64 + row) * N + nt * 64 + c4);
        tile[row * 65 + c4 + 0] = v[0]; tile[row * 65 + c4 + 1] = v[1]; tile[row * 65 + c4 + 2] = v[2]; tile[row * 65 + c4 + 3] = v[3];
      }
      __syncthreads();
      const int n = tid >> 2, kq = (tid & 3) * 16;
      unsigned o[8];
#pragma unroll
      for (int j = 0; j < 8; ++j) o[j] = pk2(tile[(kq + 2 * j) * 65 + n], tile[(kq + 2 * j + 1) * 65 + n]);
      u32x4* dst = (u32x4*)(Wt + (size_t)(nt * 64 + n) * 1024 + kt * 64 + kq);
      dst[0] = mk4(o[0], o[1], o[2], o[3]);
      dst[1] = mk4(o[4], o[5], o[6], o[7]);
      __syncthreads();
    } else {
      const int u2 = u - 2048;
      const int l = u2 / 192, cb = u2 - l * 192;
      for (int idx = tid; idx < 5120; idx += 256) {
        const int s = idx >> 10, k = idx & 1023;
        const float v = (s < 4) ? p.c[s * 1024 + k] : p.c_ctx[k];
        sc[idx] = v / (1.f + expf(-v));
      }
      __syncthreads();
      const int col = tid & 15, kg = tid >> 4;
      float acc[5] = {0.f, 0.f, 0.f, 0.f, 0.f};
      const float* wp = p.w_mod + ((size_t)l * 1024 + kg * 64) * 3072 + cb * 16 + col;
#pragma unroll 16
      for (int k = 0; k < 64; ++k) {
        const float wv = wp[(size_t)k * 3072];
#pragma unroll
        for (int s = 0; s < 5; ++s) acc[s] += sc[s * 1024 + kg * 64 + k] * wv;
      }
#pragma unroll
      for (int s = 0; s < 5; ++s) part[(kg * 5 + s) * 16 + col] = acc[s];
      __syncthreads();
      if (tid < 80) {
        const int s = tid >> 4, cc = tid & 15;
        float a = 0.f;
        for (int g = 0; g < 16; ++g) a += part[(g * 5 + s) * 16 + cc];
        float* MOD = (float*)(p.ws + OFF_MOD);
        MOD[(l * 5 + s) * 3072 + cb * 16 + cc] = a + p.b_mod[l * 3072 + cb * 16 + cc];
      }
      __syncthreads();
    }
  }
}

DI void phase_prenorm0(const Params& p, int vb, int nvb) {
  const int tid = threadIdx.x, lane = tid & 63, w = tid >> 6;
  const float* MOD = (const float*)(p.ws + OFF_MOD);
  u16* HX = (u16*)(p.ws + OFF_HX);
  for (int u = vb; u < MROWS / 4; u += nvb) {
    const int rowg = u * 4 + w;
    const int b = rowg / TT, tok = rowg - b * TT;
    const bool lat = tok < 4096;
    const float* src = lat ? p.x + ((size_t)b * 4096 + tok) * 1024 : p.ctx + ((size_t)b * 256 + (tok - 4096)) * 1024;
    const float* mod = MOD + (0 * 5 + (lat ? b : 4)) * 3072;
    f32x4 v[4]; float ss = 0.f;
#pragma unroll
    for (int j = 0; j < 4; ++j) { v[j] = *(const f32x4*)(src + j * 256 + lane * 4); ss += v[j][0] * v[j][0] + v[j][1] * v[j][1] + v[j][2] * v[j][2] + v[j][3] * v[j][3]; }
    ss = wave_sum(ss);
    const float rinv = rsqrtf(ss * (1.f / 1024.f) + 1e-6f);
#pragma unroll
    for (int j = 0; j < 4; ++j) {
      const int col = j * 256 + lane * 4;
      const f32x4 g = *(const f32x4*)(p.g_pre + col), sh = *(const f32x4*)(mod + col), scv = *(const f32x4*)(mod + 1024 + col);
      float hv[4];
#pragma unroll
      for (int e = 0; e < 4; ++e) hv[e] = (v[j][e] * rinv * g[e]) * (1.f + scv[e]) + sh[e];
      *(u32x2*)(HX + (size_t)rowg * 1024 + col) = mk2(pk2(hv[0], hv[1]), pk2(hv[2], hv[3]));
    }
  }
}

template <int MODE>
DI void gemm_phase(const Params& p, char* smem, int vb, int nvb, const u16* __restrict__ Wt, const u16* __restrict__ X, int NT) {
  u16* As = (u16*)smem;
  u16* Bs = As + 128 * 72;
  const int tid = threadIdx.x, lane = tid & 63, w = tid >> 6, r = lane & 31, h = lane >> 5;
  const int wn = w & 1, wt = w >> 1;
  const int total = 136 * NT;
  for (int u = vb; u < total; u += nvb) {
    const int mt = u / NT, nt = u - mt * NT;
    const bool ctx_tile = (mt % 34) >= 32;
    if (MODE == 2 && ctx_tile && (nt < 8 || nt >= 12)) continue;
    if (MODE == 3 && ctx_tile) continue;
    const u16* Wg = Wt + (size_t)(nt * 128) * 1024;
    const u16* Xg = X + (size_t)(mt * 128) * 1024;
    f32x16 acc[2][2];
#pragma unroll
    for (int a = 0; a < 2; ++a)
#pragma unroll
      for (int bq = 0; bq < 2; ++bq)
#pragma unroll
        for (int i = 0; i < 16; ++i) acc[a][bq][i] = 0.f;
    u32x4 ra[4], rb[4];
#pragma unroll
    for (int j = 0; j < 4; ++j) {
      const int cidx = tid + 256 * j, row = cidx >> 3, part = cidx & 7;
      ra[j] = *(const u32x4*)(Wg + (size_t)row * 1024 + part * 8);
      rb[j] = *(const u32x4*)(Xg + (size_t)row * 1024 + part * 8);
    }
    for (int kt = 0; kt < 16; ++kt) {
      __syncthreads();
#pragma unroll
      for (int j = 0; j < 4; ++j) {
        const int cidx = tid + 256 * j, row = cidx >> 3, part = cidx & 7;
        *(u32x4*)(As + row * 72 + part * 8) = ra[j];
        *(u32x4*)(Bs + row * 72 + part * 8) = rb[j];
      }
      __syncthreads();
      if (kt < 15) {
#pragma unroll
        for (int j = 0; j < 4; ++j) {
          const int cidx = tid + 256 * j, row = cidx >> 3, part = cidx & 7;
          ra[j] = *(const u32x4*)(Wg + (size_t)row * 1024 + (kt + 1) * 64 + part * 8);
          rb[j] = *(const u32x4*)(Xg + (size_t)row * 1024 + (kt + 1) * 64 + part * 8);
        }
      }
#pragma unroll
      for (int ks = 0; ks < 4; ++ks) {
        const bf16x8 a0 = *(const bf16x8*)(As + (wn * 64 + r) * 72 + ks * 16 + h * 8);
        const bf16x8 a1 = *(const bf16x8*)(As + (wn * 64 + 32 + r) * 72 + ks * 16 + h * 8);
        const bf16x8 b0 = *(const bf16x8*)(Bs + (wt * 64 + r) * 72 + ks * 16 + h * 8);
        const bf16x8 b1 = *(const bf16x8*)(Bs + (wt * 64 + 32 + r) * 72 + ks * 16 + h * 8);
        acc[0][0] = MFMA32(a0, b0, acc[0][0]);
        acc[0][1] = MFMA32(a0, b1, acc[0][1]);
        acc[1][0] = MFMA32(a1, b0, acc[1][0]);
        acc[1][1] = MFMA32(a1, b1, acc[1][1]);
      }
    }
    const int nbase = nt * 128 + wn * 64;
    if (MODE == 1 || MODE == 3) {
      float* Y = (float*)(p.ws + OFF_Y);
#pragma unroll
      for (int tb = 0; tb < 2; ++tb) {
        const int rowg = mt * 128 + wt * 64 + tb * 32 + r;
#pragma unroll
        for (int nb = 0; nb < 2; ++nb)
#pragma unroll
          for (int ig = 0; ig < 4; ++ig) {
            f32x4 v = {acc[nb][tb][4 * ig], acc[nb][tb][4 * ig + 1], acc[nb][tb][4 * ig + 2], acc[nb][tb][4 * ig + 3]};
            *(f32x4*)(Y + (size_t)rowg * 1024 + nbase + nb * 32 + 8 * ig + 4 * h) = v;
          }
      }
    } else {
      const int seg = nbase >> 6;
      int kind, hidx, QP, Gn, gateoff; const float* gain;
      if (MODE == 0) {
        QP = 512; Gn = 2;
        if (seg < 8) { kind = 0; hidx = seg; gain = p.qn_a; }
        else if (seg < 10) { kind = 1; hidx = seg - 8; gain = p.kn_a; }
        else if (seg < 12) { kind = 2; hidx = seg - 10; gain = nullptr; }
        else if (seg < 40) { kind = 3; hidx = 0; gain = nullptr; }
        else { kind = 4; hidx = 0; gain = nullptr; }
        gateoff = 2560;
      } else {
        QP = 1024; Gn = 4;
        if (seg < 16) { kind = 0; hidx = seg; gain = p.qn_c; }
        else if (seg < 20) { kind = 1; hidx = seg - 16; gain = p.kn_c; }
        else if (seg < 24) { kind = 2; hidx = seg - 20; gain = nullptr; }
        else { kind = 4; hidx = 0; gain = nullptr; }
        gateoff = 1536;
      }
      u16* Q = (u16*)(p.ws + OFF_Q);
      u16* KB = (u16*)(p.ws + OFF_KB);
      u16* VT = (u16*)(p.ws + OFF_VT);
      u16* PB = (u16*)(p.ws + OFF_PB);
      u16* G = (u16*)(p.ws + OFF_G);
#pragma unroll
      for (int tb = 0; tb < 2; ++tb) {
        const int rowg = mt * 128 + wt * 64 + tb * 32 + r;
        const int b = rowg / TT, tok = rowg - b * TT;
        const bool lat = tok < 4096;
        if (kind <= 1) {
          float ss = 0.f;
#pragma unroll
          for (int nb = 0; nb < 2; ++nb)
#pragma unroll
            for (int i = 0; i < 16; ++i) ss += acc[nb][tb][i] * acc[nb][tb][i];
          ss += __shfl_xor(ss, 32);
          const float rinv = rsqrtf(ss * (1.f / 64.f) + 1e-6f);
          const float prow = (float)(tok >> 6), pcol = (float)(tok & 63);
          const float osc = (kind == 0) ? 0.125f * 1.4426950408889634f : 1.f;
#pragma unroll
          for (int nb = 0; nb < 2; ++nb)
#pragma unroll
            for (int ig = 0; ig < 4; ++ig) {
              const int nin = nb * 32 + 8 * ig + 4 * h;
              const f32x4 gv = *(const f32x4*)(gain + nin);
              float xv[4];
#pragma unroll
              for (int e = 0; e < 4; ++e) xv[e] = acc[nb][tb][4 * ig + e] * rinv * gv[e];
              if (lat) {
#pragma unroll
                for (int pr = 0; pr < 2; ++pr) {
                  const int j = 4 * ig + 2 * h + pr;
                  const float ang = (nb == 0 ? prow : pcol) * exp2f(-(float)j * 0.8304820237218405f);
                  const float cs = __cosf(ang), sn = __sinf(ang);
                  const float x1 = xv[2 * pr], x2 = xv[2 * pr + 1];
                  xv[2 * pr] = x1 * cs - x2 * sn;
                  xv[2 * pr + 1] = x1 * sn + x2 * cs;
                }
              }
              const u32x2 o = mk2(pk2(xv[0] * osc, xv[1] * osc), pk2(xv[2] * osc, xv[3] * osc));
              if (kind == 0) *(u32x2*)(Q + (size_t)rowg * QP + hidx * 64 + nin) = o;
              else *(u32x2*)(KB + ((size_t)(b * Gn + hidx) * TT + tok) * 64 + nin) = o;
            }
        } else if (kind == 2) {
#pragma unroll
          for (int nb = 0; nb < 2; ++nb)
#pragma unroll
            for (int i = 0; i < 16; ++i) {
              const int dd = nb * 32 + (i & 3) + 8 * (i >> 2) + 4 * h;
              VT[((size_t)(b * Gn + hidx) * 64 + dd) * TT + tok] = bf1(acc[nb][tb][i]);
            }
        } else if (kind == 3) {
#pragma unroll
          for (int nb = 0; nb < 2; ++nb)
#pragma unroll
            for (int ig = 0; ig < 4; ++ig)
              *(u32x2*)(PB + (size_t)rowg * 1792 + (nbase - 768) + nb * 32 + 8 * ig + 4 * h) =
                  mk2(pk2(acc[nb][tb][4 * ig], acc[nb][tb][4 * ig + 1]), pk2(acc[nb][tb][4 * ig + 2], acc[nb][tb][4 * ig + 3]));
        } else {
#pragma unroll
          for (int nb = 0; nb < 2; ++nb)
#pragma unroll
            for (int ig = 0; ig < 4; ++ig)
              *(u32x2*)(G + (size_t)rowg * 1024 + (nbase - gateoff) + nb * 32 + 8 * ig + 4 * h) =
                  mk2(pk2(silu(acc[nb][tb][4 * ig]), silu(acc[nb][tb][4 * ig + 1])), pk2(silu(acc[nb][tb][4 * ig + 2]), silu(acc[nb][tb][4 * ig + 3])));
        }
      }
    }
  }
}

DI void attn_block(const Params& p, char* smem, int QP, int Gn, int b, int head, int qtok0,
                   int t_first, int n_first, int t_second, int n_second, bool win, bool has_sink, float sink2) {
  u16* Ks = (u16*)smem;
  u16* Vs = Ks + 64 * 72;
  const u16* Q = (const u16*)(p.ws + OFF_Q);
  const u16* G = (const u16*)(p.ws + OFF_G);
  u16* A2 = (u16*)(p.ws + OFF_HX);
  const int tid = threadIdx.x, lane = tid & 63, w = tid >> 6, r = lane & 31, h = lane >> 5;
  const int g = head >> 2;
  const u16* Kg = (const u16*)(p.ws + OFF_KB) + (size_t)(b * Gn + g) * TT * 64;
  const u16* Vg = (const u16*)(p.ws + OFF_VT) + (size_t)(b * Gn + g) * 64 * TT;
  const int qtok = qtok0 + w * 32 + r;
  const size_t qrow = (size_t)b * TT + qtok;
  bf16x8 qf[4];
#pragma unroll
  for (int ks = 0; ks < 4; ++ks) qf[ks] = *(const bf16x8*)(Q + qrow * QP + head * 64 + ks * 16 + h * 8);
  f32x16 o[2];
#pragma unroll
  for (int db = 0; db < 2; ++db)
#pragma unroll
    for (int i = 0; i < 16; ++i) o[db][i] = 0.f;
  float m = -INFINITY, l = 0.f;
  const int ntot = n_first + n_second;
  u32x4 rk[2], rv[2];
  {
    const int tile = (0 < n_first) ? t_first : t_second;
#pragma unroll
    for (int j = 0; j < 2; ++j) {
      const int cidx = tid + 256 * j, row = cidx >> 3, part = cidx & 7;
      rk[j] = *(const u32x4*)(Kg + (size_t)(tile * 64 + row) * 64 + part * 8);
      rv[j] = *(const u32x4*)(Vg + (size_t)row * TT + tile * 64 + part * 8);
    }
  }
  for (int it = 0; it < ntot; ++it) {
    const int tile = (it < n_first) ? (t_first + it) : (t_second + it - n_first);
    __syncthreads();
#pragma unroll
    for (int j = 0; j < 2; ++j) {
      const int cidx = tid + 256 * j, row = cidx >> 3, part = cidx & 7;
      *(u32x4*)(Ks + row * 72 + part * 8) = rk[j];
      *(u32x4*)(Vs + row * 72 + part * 8) = rv[j];
    }
    __syncthreads();
    if (it + 1 < ntot) {
      const int tn = (it + 1 < n_first) ? (t_first + it + 1) : (t_second + it + 1 - n_first);
#pragma unroll
      for (int j = 0; j < 2; ++j) {
        const int cidx = tid + 256 * j, row = cidx >> 3, part = cidx & 7;
        rk[j] = *(const u32x4*)(Kg + (size_t)(tn * 64 + row) * 64 + part * 8);
        rv[j] = *(const u32x4*)(Vg + (size_t)row * TT + tn * 64 + part * 8);
      }
    }
    f32x16 s[2];
#pragma unroll
    for (int kb = 0; kb < 2; ++kb) {
#pragma unroll
      for (int i = 0; i < 16; ++i) s[kb][i] = 0.f;
#pragma unroll
      for (int ks = 0; ks < 4; ++ks) {
        const bf16x8 a = *(const bf16x8*)(Ks + (kb * 32 + r) * 72 + ks * 16 + h * 8);
        s[kb] = MFMA32(a, qf[ks], s[kb]);
      }
    }
    if (win && tile < 64) {
#pragma unroll
      for (int kb = 0; kb < 2; ++kb)
#pragma unroll
        for (int i = 0; i < 16; ++i) {
          const int key = tile * 64 + kb * 32 + (i & 3) + 8 * (i >> 2) + 4 * h;
          const int dl = key - qtok;
          if (dl > 128 || dl < -128) s[kb][i] = -INFINITY;
        }
    }
    float mx = -INFINITY;
#pragma unroll
    for (int kb = 0; kb < 2; ++kb)
#pragma unroll
      for (int i = 0; i < 16; ++i) mx = fmaxf(mx, s[kb][i]);
    mx = fmaxf(mx, __shfl_xor(mx, 32));
    const float mn = fmaxf(m, mx);
    const float alpha = fexp2(m - mn);
    m = mn;
    float ps = 0.f;
#pragma unroll
    for (int kb = 0; kb < 2; ++kb)
#pragma unroll
      for (int i = 0; i < 16; ++i) { s[kb][i] = fexp2(s[kb][i] - mn); ps += s[kb][i]; }
    l = l * alpha + ps;
#pragma unroll
    for (int db = 0; db < 2; ++db)
#pragma unroll
      for (int i = 0; i < 16; ++i) o[db][i] *= alpha;
#pragma unroll
    for (int kb = 0; kb < 2; ++kb)
#pragma unroll
      for (int st = 0; st < 2; ++st) {
        const unsigned p0 = pk2(s[kb][8 * st + 0], s[kb][8 * st + 1]), p1 = pk2(s[kb][8 * st + 2], s[kb][8 * st + 3]);
        const unsigned p2 = pk2(s[kb][8 * st + 4], s[kb][8 * st + 5]), p3 = pk2(s[kb][8 * st + 6], s[kb][8 * st + 7]);
        const u32x4 pu = mk4(p0, p1, p2, p3);
        const bf16x8 pf = __builtin_bit_cast(bf16x8, pu);
#pragma unroll
        for (int db = 0; db < 2; ++db) {
          const s16x4 lo = *(const s16x4*)(Vs + (db * 32 + r) * 72 + kb * 32 + 16 * st + 4 * h);
          const s16x4 hi = *(const s16x4*)(Vs + (db * 32 + r) * 72 + kb * 32 + 16 * st + 8 + 4 * h);
          const bf16x8 vf = __builtin_shufflevector(lo, hi, 0, 1, 2, 3, 4, 5, 6, 7);
          o[db] = MFMA32(vf, pf, o[db]);
        }
      }
  }
  l += __shfl_xor(l, 32);
  if (has_sink) {
    const float mn = fmaxf(m, sink2);
    const float alpha = fexp2(m - mn);
    l = l * alpha + fexp2(sink2 - mn);
#pragma unroll
    for (int db = 0; db < 2; ++db)
#pragma unroll
      for (int i = 0; i < 16; ++i) o[db][i] *= alpha;
  }
  const float inv = 1.f / l;
#pragma unroll
  for (int db = 0; db < 2; ++db)
#pragma unroll
    for (int ig = 0; ig < 4; ++ig) {
      const int dd = db * 32 + 8 * ig + 4 * h;
      const u32x2 gt = *(const u32x2*)(G + qrow * 1024 + head * 64 + dd);
      const float v0 = o[db][4 * ig] * inv * bf_lo(gt.x), v1 = o[db][4 * ig + 1] * inv * bf_hi(gt.x);
      const float v2 = o[db][4 * ig + 2] * inv * bf_lo(gt.y), v3 = o[db][4 * ig + 3] * inv * bf_hi(gt.y);
      *(u32x2*)(A2 + qrow * 1024 + head * 64 + dd) = mk2(pk2(v0, v1), pk2(v2, v3));
    }
}

DI int scan_tok(int s, int d) {
  if (s < 256) return 4096 + (d ? 255 - s : s);
  const int i = s - 256;
  return d ? 4095 - i : i;
}

template <class T> DI T ldgo(const void* base, unsigned byteoff) { return *(const T*)((const char*)base + byteoff); }
DI int scan_segoff(int sg, int d, int h) { return sg < 3 ? sg * 512 + h * 64 : 1536 + (sg - 3) * 128 + d * 64; }
DI float tanh_fast(float x) { const float e = __expf(2.f * x); return 1.f - 2.f / (e + 1.f); }

DI void scan_chain(const Params& p, char* smem, int chain) {
  const int tid = threadIdx.x, lane = tid & 63, w = tid >> 6;
  const int d = chain >> 5, b = (chain >> 3) & 3, h = chain & 7;
  float* REC = (float*)smem;
  float* RS = REC + 16 * 328;
  float* KSs = RS + 1024;
  float* VS = KSs + 1024;
  float* YB = VS + 1024;
  float* INVN = YB + 1024;
  float* BON = INVN + 16;
  float* CST = BON + 64;
  u16* ZW = (u16*)(CST + 768);
  u16* ZA = ZW + 16 * 72;
  u16* RAW = ZA + 16 * 72;
  const u16* PB = (const u16*)(p.ws + OFF_PB);
  u16* OB = (u16*)(p.ws + OFF_OB);

  if (tid < 64) {
    const unsigned hc = (unsigned)(h * 64 + tid) * 4u, dhc = (unsigned)(d * 512 + h * 64 + tid) * 4u;
#pragma unroll
    for (int sg = 0; sg < 5; ++sg) CST[sg * 64 + tid] = ldgo<float>(p.mu_b, (unsigned)(scan_segoff(sg, d, h) + tid) * 4u);
    CST[320 + tid] = ldgo<float>(p.kk_b, hc);
    CST[384 + tid] = ldgo<float>(p.gn_w_b, hc);
    CST[448 + tid] = ldgo<float>(p.gn_b_b, hc);
    CST[512 + tid] = ldgo<float>(p.w0_b, dhc);
    CST[576 + tid] = ldgo<float>(p.a0_b, dhc);
    CST[640 + tid] = ldgo<float>(p.ka_b, hc);
    CST[704 + tid] = ldgo<float>(p.rk_b, hc);
  }
  const int t1 = tid >> 4, q = tid & 15, c4 = q * 4;
  const int hhi = tid / 80, hsg = (tid % 80) >> 4;
  const int c2 = 16 * w + (lane & 15), tg = lane >> 4;
  bf16x8 bw[2], ba[2];
#pragma unroll
  for (int ks = 0; ks < 2; ++ks) {
    unsigned uw[4], ua[4];
#pragma unroll
    for (int e2 = 0; e2 < 4; ++e2) {
      const int j0 = tg * 8 + 32 * ks + 2 * e2;
      const unsigned o0 = (unsigned)((d * 64 + j0) * 512 + h * 64 + c2) * 4u;
      uw[e2] = pk2(ldgo<float>(p.w2_b, o0), ldgo<float>(p.w2_b, o0 + 2048u));
      ua[e2] = pk2(ldgo<float>(p.a2_b, o0), ldgo<float>(p.a2_b, o0 + 2048u));
    }
    bw[ks] = __builtin_bit_cast(bf16x8, mk4(uw[0], uw[1], uw[2], uw[3]));
    ba[ks] = __builtin_bit_cast(bf16x8, mk4(ua[0], ua[1], ua[2], ua[3]));
  }
  const int g8 = lane & 7, row0 = 16 * w + 2 * (lane >> 3);
  float S0[8], S1[8];
#pragma unroll
  for (int j = 0; j < 8; ++j) { S0[j] = 0.f; S1[j] = 0.f; }

  u32x2 pr[5], ph = mk2(0u, 0u);
  const unsigned pbase = (unsigned)(b * TT) * 3584u;
#define SCAN_LOAD(CH)                                                                                                   \
  {                                                                                                                     \
    const unsigned ro_ = pbase + (unsigned)scan_tok((CH) * 16 + t1, d) * 3584u + (unsigned)c4 * 2u;                     \
    _Pragma("unroll") for (int sg = 0; sg < 5; ++sg) pr[sg] = ldgo<u32x2>(PB, ro_ + (unsigned)scan_segoff(sg, d, h) * 2u); \
    if (tid < 160) {                                                                                                    \
      const int sh_ = hhi ? (CH) * 16 + 16 : (CH) * 16 - 1;                                                             \
      const bool valid_ = hhi ? (sh_ != 256 && sh_ != 4352) : (sh_ != -1 && sh_ != 255);                               \
      ph = mk2(0u, 0u);                                                                                                 \
      if (valid_) ph = ldgo<u32x2>(PB, pbase + (unsigned)scan_tok(sh_, d) * 3584u + (unsigned)(scan_segoff(hsg, d, h) + c4) * 2u); \
    }                                                                                                                   \
  }
  SCAN_LOAD(0)
  int tok_prev = 0;
  for (int ch = 0; ch <= 272; ++ch) {
    if (ch < 272) {
#pragma unroll
      for (int sg = 0; sg < 5; ++sg) *(u32x2*)(RAW + (t1 + 1) * 320 + sg * 64 + c4) = pr[sg];
      if (tid < 160) *(u32x2*)(RAW + (hhi * 17) * 320 + hsg * 64 + c4) = ph;
    }
    __syncthreads();
    if (ch > 0) {
      const f32x4 y = *(const f32x4*)(YB + t1 * 64 + c4);
      const float mean = reduce16(y[0] + y[1] + y[2] + y[3]) * (1.f / 64.f);
      const float d0 = y[0] - mean, d1 = y[1] - mean, d2 = y[2] - mean, d3 = y[3] - mean;
      const float var = reduce16(d0 * d0 + d1 * d1 + d2 * d2 + d3 * d3) * (1.f / 64.f);
      const float rstd = rsqrtf(var + 64e-5f);
      const f32x4 bq = *(const f32x4*)(BON + t1 * 4);
      const float bon = bq[0] + bq[1] + bq[2] + bq[3];
      const f32x4 v4 = *(const f32x4*)(VS + t1 * 64 + c4);
      const f32x4 gnw = *(const f32x4*)(CST + 384 + c4), gnb = *(const f32x4*)(CST + 448 + c4);
      const float o0 = d0 * rstd * gnw[0] + gnb[0] + bon * v4[0], o1 = d1 * rstd * gnw[1] + gnb[1] + bon * v4[1];
      const float o2 = d2 * rstd * gnw[2] + gnb[2] + bon * v4[2], o3 = d3 * rstd * gnw[3] + gnb[3] + bon * v4[3];
      *(u32x2*)((char*)OB + (unsigned)(((d * MROWS + b * TT + tok_prev) * 512 + h * 64 + c4) * 2)) = mk2(pk2(o0, o1), pk2(o2, o3));
    }
    if (ch == 272) break;
    {
      tok_prev = scan_tok(ch * 16 + t1, d);
      float sv[5][4];
#pragma unroll
      for (int sg = 0; sg < 5; ++sg) {
        const u32x2 cu = *(const u32x2*)(RAW + (t1 + 1) * 320 + sg * 64 + c4);
        const u32x2 pu = *(const u32x2*)(RAW + t1 * 320 + sg * 64 + c4);
        const u32x2 nu = *(const u32x2*)(RAW + (t1 + 2) * 320 + sg * 64 + c4);
        const f32x4 mu = *(const f32x4*)(CST + sg * 64 + c4);
        const float c0 = bf_lo(cu.x), c1 = bf_hi(cu.x), c2v = bf_lo(cu.y), c3 = bf_hi(cu.y);
        const float n0 = 0.5f * (bf_lo(pu.x) + bf_lo(nu.x)), n1 = 0.5f * (bf_hi(pu.x) + bf_hi(nu.x));
        const float n2 = 0.5f * (bf_lo(pu.y) + bf_lo(nu.y)), n3 = 0.5f * (bf_hi(pu.y) + bf_hi(nu.y));
        sv[sg][0] = c0 + mu[0] * (n0 - c0); sv[sg][1] = c1 + mu[1] * (n1 - c1);
        sv[sg][2] = c2v + mu[2] * (n2 - c2v); sv[sg][3] = c3 + mu[3] * (n3 - c3);
      }
      *(f32x4*)(RS + t1 * 64 + c4) = (f32x4){sv[0][0], sv[0][1], sv[0][2], sv[0][3]};
      *(f32x4*)(KSs + t1 * 64 + c4) = (f32x4){sv[1][0], sv[1][1], sv[1][2], sv[1][3]};
      *(f32x4*)(VS + t1 * 64 + c4) = (f32x4){sv[2][0], sv[2][1], sv[2][2], sv[2][3]};
      *(u32x2*)(ZW + t1 * 72 + c4) = mk2(pk2(tanh_fast(sv[3][0]), tanh_fast(sv[3][1])), pk2(tanh_fast(sv[3][2]), tanh_fast(sv[3][3])));
      *(u32x2*)(ZA + t1 * 72 + c4) = mk2(pk2(sv[4][0], sv[4][1]), pk2(sv[4][2], sv[4][3]));
      const f32x4 kkc1 = *(const f32x4*)(CST + 320 + c4);
      float ssq = 0.f;
#pragma unroll
      for (int e = 0; e < 4; ++e) { const float kq = sv[1][e] * kkc1[e]; ssq += kq * kq; }
      ssq = reduce16(ssq);
      if (q == 0) INVN[t1] = 1.f / fmaxf(sqrtf(ssq), 1e-12f);
    }
    if (ch + 1 < 272) SCAN_LOAD(ch + 1)
    __syncthreads();
    {
      const bf16x8 az0 = *(const bf16x8*)(ZW + (lane & 15) * 72 + tg * 8), az1 = *(const bf16x8*)(ZW + (lane & 15) * 72 + tg * 8 + 32);
      const bf16x8 aa0 = *(const bf16x8*)(ZA + (lane & 15) * 72 + tg * 8), aa1 = *(const bf16x8*)(ZA + (lane & 15) * 72 + tg * 8 + 32);
      f32x4 xw = {0.f, 0.f, 0.f, 0.f}, xa = {0.f, 0.f, 0.f, 0.f};
      xw = MFMA16(az0, bw[0], xw); xw = MFMA16(az1, bw[1], xw);
      xa = MFMA16(aa0, ba[0], xa); xa = MFMA16(aa1, ba[1], xa);
      const float w0c = CST[512 + c2], a0c = CST[576 + c2], kkc2 = CST[320 + c2], kac = CST[640 + c2], rkc = CST[704 + c2];
#pragma unroll
      for (int i = 0; i < 4; ++i) {
        const int t = tg * 4 + i;
        const float wl = w0c + xw[i];
        const float sp = fmaxf(-wl, 0.f) + __logf(1.f + __expf(-fabsf(wl)));
        const float wdec = __expf(-__expf(-sp - 0.5f));
        const float a = 1.f / (1.f + __expf(-(a0c + xa[i])));
        const float k = KSs[t * 64 + c2], rr = RS[t * 64 + c2];
        const float kk = k * kkc2 * INVN[t];
        const float bv = kk * a;
        const float km = k * (1.f + (a - 1.f) * kac);
        float* R = REC + t * 328;
        R[c2] = wdec; R[64 + c2] = kk; R[128 + c2] = bv; R[192 + c2] = km; R[256 + c2] = wdec * rr;
        const float brp = reduce16(bv * rr), krp = reduce16(km * rr), bop = reduce16(rr * km * rkc);
        if ((lane & 15) == 0) { R[320 + w] = brp; R[324 + w] = krp; BON[t * 4 + w] = bop; }
      }
    }
    __syncthreads();
#pragma unroll 2
    for (int t = 0; t < 16; ++t) {
      const float* R = REC + t * 328 + 8 * g8;
      const f32x4 W0 = *(const f32x4*)(R), W1 = *(const f32x4*)(R + 4);
      const f32x4 K0 = *(const f32x4*)(R + 64), K1 = *(const f32x4*)(R + 68);
      const f32x4 B0 = *(const f32x4*)(R + 128), B1 = *(const f32x4*)(R + 132);
      const f32x4 M0 = *(const f32x4*)(R + 192), M1 = *(const f32x4*)(R + 196);
      const f32x4 R0 = *(const f32x4*)(R + 256), R1 = *(const f32x4*)(R + 260);
      const f32x2 vv = *(const f32x2*)(VS + t * 64 + row0);
      const f32x4 brq = *(const f32x4*)(REC + t * 328 + 320), krq = *(const f32x4*)(REC + t * 328 + 324);
      const float br = (brq[0] + brq[1]) + (brq[2] + brq[3]), kr = (krq[0] + krq[1]) + (krq[2] + krq[3]);
      float sa0 = 0.f, sa1 = 0.f, y0 = 0.f, y1 = 0.f;
#pragma unroll
      for (int j = 0; j < 4; ++j) {
        sa0 += S0[j] * K0[j]; sa1 += S1[j] * K0[j]; y0 += S0[j] * R0[j]; y1 += S1[j] * R0[j];
      }
#pragma unroll
      for (int j = 0; j < 4; ++j) {
        sa0 += S0[4 + j] * K1[j]; sa1 += S1[4 + j] * K1[j]; y0 += S0[4 + j] * R1[j]; y1 += S1[4 + j] * R1[j];
      }
      sa0 = reduce8(sa0); sa1 = reduce8(sa1); y0 = reduce8(y0); y1 = reduce8(y1);
      y0 = y0 - sa0 * br + vv[0] * kr;
      y1 = y1 - sa1 * br + vv[1] * kr;
#pragma unroll
      for (int j = 0; j < 4; ++j) {
        S0[j] = S0[j] * W0[j] + (vv[0] * M0[j] - sa0 * B0[j]);
        S1[j] = S1[j] * W0[j] + (vv[1] * M0[j] - sa1 * B0[j]);
        S0[4 + j] = S0[4 + j] * W1[j] + (vv[0] * M1[j] - sa0 * B1[j]);
        S1[4 + j] = S1[4 + j] * W1[j] + (vv[1] * M1[j] - sa1 * B1[j]);
      }
      if (g8 == 0) *(f32x2*)(YB + t * 64 + row0) = (f32x2){y0, y1};
    }
  }
#undef SCAN_LOAD
}

DI void phase_mixer0(const Params& p, char* smem, int vb, int nvb) {
#ifndef NO_SCAN
  if (vb < 64) { scan_chain(p, smem, vb); return; }
#endif
#ifndef NO_ATTN0
  const int nab = nvb - 64;
  for (int it = vb - 64; it < 1088; it += nab) {
    if (it < 1024) {
      const int b = it >> 8, head = (it >> 5) & 7, qb = it & 31;
      attn_block(p, smem, 512, 2, b, head, qb * 128, 0, 68, 0, 0, false, false, 0.f);
    } else {
      const int j = it - 1024;
      const int b = j >> 4, head = (j >> 1) & 7, qb = j & 1;
      attn_block(p, smem, 512, 2, b, head, 4096 + qb * 128, 64, 4, 0, 0, false, false, 0.f);
    }
  }
#endif
}

DI void phase_combine(const Params& p, int vb, int nvb) {
  const u16* OB = (const u16*)(p.ws + OFF_OB);
  const u16* G = (const u16*)(p.ws + OFF_G);
  u16* A2 = (u16*)(p.ws + OFF_HX);
  for (int u = vb; u < 4352; u += nvb) {
    const size_t idx = ((size_t)u * 256 + threadIdx.x) * 8;
    const size_t row = idx >> 9; const int cc = (int)(idx & 511);
    const u32x4 a = *(const u32x4*)(OB + row * 512 + cc);
    const u32x4 bq = *(const u32x4*)(OB + ((size_t)MROWS + row) * 512 + cc);
    const u32x4 gq = *(const u32x4*)(G + row * 1024 + 512 + cc);
    u32x4 o;
    o.x = pk2((bf_lo(a.x) + bf_lo(bq.x)) * bf_lo(gq.x), (bf_hi(a.x) + bf_hi(bq.x)) * bf_hi(gq.x));
    o.y = pk2((bf_lo(a.y) + bf_lo(bq.y)) * bf_lo(gq.y), (bf_hi(a.y) + bf_hi(bq.y)) * bf_hi(gq.y));
    o.z = pk2((bf_lo(a.z) + bf_lo(bq.z)) * bf_lo(gq.z), (bf_hi(a.z) + bf_hi(bq.z)) * bf_hi(gq.z));
    o.w = pk2((bf_lo(a.w) + bf_lo(bq.w)) * bf_lo(gq.w), (bf_hi(a.w) + bf_hi(bq.w)) * bf_hi(gq.w));
    *(u32x4*)(A2 + row * 1024 + 512 + cc) = o;
  }
}

DI void phase_post(const Params& p, int vb, int nvb) {
  const int tid = threadIdx.x, lane = tid & 63, w = tid >> 6;
  const float* MOD = (const float*)(p.ws + OFF_MOD);
  const float* Y = (const float*)(p.ws + OFF_Y);
  u16* HX = (u16*)(p.ws + OFF_HX);
  for (int u = vb; u < MROWS / 4; u += nvb) {
    const int rowg = u * 4 + w;
    const int b = rowg / TT, tok = rowg - b * TT;
    const bool lat = tok < 4096;
    const float* src = lat ? p.x + ((size_t)b * 4096 + tok) * 1024 : p.ctx + ((size_t)b * 256 + (tok - 4096)) * 1024;
    const float* mod0 = MOD + (0 * 5 + (lat ? b : 4)) * 3072;
    const float* mod1 = MOD + (1 * 5 + (lat ? b : 4)) * 3072;
    f32x4 yv[4]; float ss = 0.f;
#pragma unroll
    for (int j = 0; j < 4; ++j) { yv[j] = *(const f32x4*)(Y + (size_t)rowg * 1024 + j * 256 + lane * 4); ss += yv[j][0] * yv[j][0] + yv[j][1] * yv[j][1] + yv[j][2] * yv[j][2] + yv[j][3] * yv[j][3]; }
    ss = wave_sum(ss);
    const float rinv = rsqrtf(ss * (1.f / 1024.f) + 1e-6f);
    f32x4 x1[4]; float s1 = 0.f;
#pragma unroll
    for (int j = 0; j < 4; ++j) {
      const int col = j * 256 + lane * 4;
      const f32x4 xv = *(const f32x4*)(src + col), gp = *(const f32x4*)(p.g_post + col), gt = *(const f32x4*)(mod0 + 2048 + col);
#pragma unroll
      for (int e = 0; e < 4; ++e) { x1[j][e] = xv[e] + gt[e] * (yv[j][e] * rinv * gp[e]); s1 += x1[j][e] * x1[j][e]; }
      if (lat) *(f32x4*)(p.out + ((size_t)b * 4096 + tok) * 1024 + col) = x1[j];
    }
    s1 = wave_sum(s1);
    const float rinv1 = rsqrtf(s1 * (1.f / 1024.f) + 1e-6f);
#pragma unroll
    for (int j = 0; j < 4; ++j) {
      const int col = j * 256 + lane * 4;
      const f32x4 g = *(const f32x4*)(p.g_pre + 1024 + col), sh = *(const f32x4*)(mod1 + col), scv = *(const f32x4*)(mod1 + 1024 + col);
      float hv[4];
#pragma unroll
      for (int e = 0; e < 4; ++e) hv[e] = (x1[j][e] * rinv1 * g[e]) * (1.f + scv[e]) + sh[e];
      *(u32x2*)(HX + (size_t)rowg * 1024 + col) = mk2(pk2(hv[0], hv[1]), pk2(hv[2], hv[3]));
    }
  }
}

DI void phase_attn1(const Params& p, char* smem, int vb, int nvb) {
  for (int it = vb; it < 2048; it += nvb) {
    const int b = it >> 9, head = (it >> 5) & 15, qb = it & 31;
    const int q0 = qb * 128;
    const int lo = (q0 - 128 < 0) ? 0 : q0 - 128, hi = (q0 + 256 > 4096) ? 4096 : q0 + 256;
    attn_block(p, smem, 1024, 4, b, head, q0, 64, 4, lo >> 6, (hi - lo) >> 6, true, true, p.sink_c[head] * 1.4426950408889634f);
  }
}

DI void phase_final(const Params& p, int vb, int nvb) {
  const int tid = threadIdx.x, lane = tid & 63, w = tid >> 6;
  const float* MOD = (const float*)(p.ws + OFF_MOD);
  const float* Y = (const float*)(p.ws + OFF_Y);
  for (int u = vb; u < 4096; u += nvb) {
    const int rowl = u * 4 + w;
    const int b = rowl >> 12, tok = rowl & 4095;
    const size_t rowg = (size_t)b * TT + tok;
    const float* mod1 = MOD + (1 * 5 + b) * 3072;
    f32x4 yv[4]; float ss = 0.f;
#pragma unroll
    for (int j = 0; j < 4; ++j) { yv[j] = *(const f32x4*)(Y + rowg * 1024 + j * 256 + lane * 4); ss += yv[j][0] * yv[j][0] + yv[j][1] * yv[j][1] + yv[j][2] * yv[j][2] + yv[j][3] * yv[j][3]; }
    ss = wave_sum(ss);
    const float rinv = rsqrtf(ss * (1.f / 1024.f) + 1e-6f);
#pragma unroll
    for (int j = 0; j < 4; ++j) {
      const int col = j * 256 + lane * 4;
      float* op = p.out + (size_t)rowl * 1024 + col;
      const f32x4 xv = *(const f32x4*)op, gp = *(const f32x4*)(p.g_post + 1024 + col), gt = *(const f32x4*)(mod1 + 2048 + col);
      f32x4 ov;
#pragma unroll
      for (int e = 0; e < 4; ++e) ov[e] = xv[e] + gt[e] * (yv[j][e] * rinv * gp[e]);
      *(f32x4*)op = ov;
    }
  }
}

#ifndef PHMASK
#define PHMASK 0x7ff
#endif
#ifndef LB2
#define LB2 2
#endif
#define PH_ON(i) (((PHMASK) >> (i)) & 1)
static constexpr int SMEM_BYTES = 57344;
__global__ void __launch_bounds__(256, LB2) hybrid_fwd(Params p) {
  __shared__ __attribute__((aligned(16))) char smem[SMEM_BYTES];
  cg::grid_group grid = cg::this_grid();
  const int vb = blockIdx.x, nvb = gridDim.x;
#define RUN_PH(i, call)                                            \
  if (PH_ON(i) && p.ph_lo <= (i) && (i) < p.ph_hi) { call; }         \
  if (p.ph_lo <= (i) && (i) + 1 < p.ph_hi) grid.sync();
  RUN_PH(0, phase_prep(p, smem, vb, nvb))
  RUN_PH(1, phase_prenorm0(p, vb, nvb))
  RUN_PH(2, gemm_phase<0>(p, smem, vb, nvb, (const u16*)(p.ws + OFF_WT0), (const u16*)(p.ws + OFF_HX), 28))
  RUN_PH(3, phase_mixer0(p, smem, vb, nvb))
  RUN_PH(4, phase_combine(p, vb, nvb))
  RUN_PH(5, gemm_phase<1>(p, smem, vb, nvb, (const u16*)(p.ws + OFF_WT1), (const u16*)(p.ws + OFF_HX), 8))
  RUN_PH(6, phase_post(p, vb, nvb))
  RUN_PH(7, gemm_phase<2>(p, smem, vb, nvb, (const u16*)(p.ws + OFF_WT2), (const u16*)(p.ws + OFF_HX), 20))
  RUN_PH(8, phase_attn1(p, smem, vb, nvb))
  RUN_PH(9, gemm_phase<3>(p, smem, vb, nvb, (const u16*)(p.ws + OFF_WT3), (const u16*)(p.ws + OFF_HX), 8))
  RUN_PH(10, phase_final(p, vb, nvb))
#undef RUN_PH
}

extern "C" void kernel_launch(void* const* d_in, const int* in_sizes, int n_in, void* d_out, int out_size, void* d_ws, size_t ws_size, hipStream_t stream) {
  static int grid_blocks = 0;
  if (grid_blocks == 0) {
    if (n_in != 27 || ws_size < WS_END) { fprintf(stderr, "kernel_launch: expected 27 inputs and >= %zu bytes of workspace (got %d, %zu)\n", (size_t)WS_END, n_in, ws_size); grid_blocks = -1; return; }
    int dev = 0, cus = 0, per_cu = 0;
    hipGetDevice(&dev);
    hipDeviceGetAttribute(&cus, hipDeviceAttributeMultiprocessorCount, dev);
    hipOccupancyMaxActiveBlocksPerMultiprocessor(&per_cu, hybrid_fwd, 256, 0);
    if (per_cu < 1) per_cu = 1;
    if (per_cu > 2) per_cu = 2;
    grid_blocks = cus * per_cu;
    fprintf(stderr, "kernel_launch: cus %d per_cu %d grid %d\n", cus, per_cu, grid_blocks);
  }
  if (grid_blocks < 0) return;
  Params p;
  memset(&p, 0, sizeof(p));
  const float** pp = (const float**)&p;
  for (int i = 0; i < 27; ++i) pp[i] = (const float*)d_in[i];
  p.out = (float*)d_out;
  p.ws = (unsigned char*)d_ws;
#if N_LAUNCH_MODE == 1
  p.ph_lo = 0; p.ph_hi = NPH;
  void* args[] = {&p};
  hipError_t e = hipLaunchCooperativeKernel((void*)hybrid_fwd, dim3(grid_blocks), dim3(256), args, 0, stream);
  if (e != hipSuccess) fprintf(stderr, "cooperative launch failed: %s (grid %d)\n", hipGetErrorString(e), grid_blocks);
#else
  for (int ph = 0; ph < NPH; ++ph) {
    p.ph_lo = ph; p.ph_hi = ph + 1;
    hipLaunchKernelGGL(hybrid_fwd, dim3(grid_blocks), dim3(256), 0, stream, p);
  }
#endif
}
```

```cpp
#include <hip/hip_runtime.h>
#include <hip/hip_cooperative_groups.h>
#include <cstdio>
#include <cstdint>
#include <cstring>
namespace cg = cooperative_groups;

#ifndef N_LAUNCH_MODE
#define N_LAUNCH_MODE 1
#endif

typedef __attribute__((ext_vector_type(8))) short bf16x8;
typedef __attribute__((ext_vector_type(4))) short s16x4;
typedef __attribute__((ext_vector_type(4))) float f32x4;
typedef __attribute__((ext_vector_type(2))) float f32x2;
typedef __attribute__((ext_vector_type(16))) float f32x16;
typedef __attribute__((ext_vector_type(2))) __bf16 bf16x2_t;
typedef unsigned short u16;
typedef __attribute__((ext_vector_type(4))) unsigned u32x4;
typedef __attribute__((ext_vector_type(2))) unsigned u32x2;
#define DI __device__ __forceinline__
#define MFMA32(a, b, c) __builtin_amdgcn_mfma_f32_32x32x16_bf16((a), (b), (c), 0, 0, 0)
#define MFMA16(a, b, c) __builtin_amdgcn_mfma_f32_16x16x32_bf16((a), (b), (c), 0, 0, 0)

static constexpr int TT = 4352;
static constexpr int MROWS = 4 * TT;
static constexpr int NPH = 11;

static constexpr size_t OFF_WT0 = 0;
static constexpr size_t OFF_WT1 = OFF_WT0 + 7340032;
static constexpr size_t OFF_WT2 = OFF_WT1 + 2097152;
static constexpr size_t OFF_WT3 = OFF_WT2 + 5242880;
static constexpr size_t OFF_MOD = OFF_WT3 + 2097152;
static constexpr size_t OFF_HX  = OFF_MOD + 131072;
static constexpr size_t OFF_Q   = OFF_HX + 35651584;
static constexpr size_t OFF_KB  = OFF_Q + 35651584;
static constexpr size_t OFF_VT  = OFF_KB + 8912896;
static constexpr size_t OFF_PB  = OFF_VT + 8912896;
static constexpr size_t OFF_G   = OFF_PB + 62390272;
static constexpr size_t OFF_OB  = OFF_G + 35651584;
static constexpr size_t OFF_VSH = OFF_OB + 35651584;
static constexpr size_t OFF_BONS = OFF_VSH + 17825792;
static constexpr size_t OFF_BAR = OFF_BONS + 1114112;
static constexpr size_t OFF_FLAGS = OFF_BAR + 16384;
static constexpr size_t WS_END  = OFF_FLAGS + 131072;
static constexpr size_t OFF_Y   = OFF_PB;

struct Params {
  const float *x, *c, *ctx, *c_ctx, *w_mod, *b_mod, *g_pre, *g_post, *w_in_even, *w_out_even, *qn_a, *kn_a,
      *mu_b, *w0_b, *w2_b, *a0_b, *a2_b, *kk_b, *ka_b, *rk_b, *gn_w_b, *gn_b_b, *w_in_odd, *w_out_odd, *qn_c, *kn_c, *sink_c;
  float* out;
  unsigned char* ws;
  int ph_lo, ph_hi;
};

DI u32x4 mk4(unsigned a, unsigned b, unsigned c, unsigned d) { u32x4 v = {a, b, c, d}; return v; }
DI u32x2 mk2(unsigned a, unsigned b) { u32x2 v = {a, b}; return v; }
DI unsigned pk2(float lo, float hi) { f32x2 v = {lo, hi}; bf16x2_t b = __builtin_convertvector(v, bf16x2_t); return __builtin_bit_cast(unsigned, b); }
DI u16 bf1(float x) { return (u16)(pk2(x, 0.f) & 0xffffu); }
DI float bf_lo(unsigned u) { return __uint_as_float(u << 16); }
DI float bf_hi(unsigned u) { return __uint_as_float(u & 0xffff0000u); }
template <int CTRL> DI float dppf(float x) { return __int_as_float(__builtin_amdgcn_update_dpp(0, __float_as_int(x), CTRL, 0xF, 0xF, true)); }
DI float reduce16(float x) { x += dppf<0xB1>(x); x += dppf<0x4E>(x); x += dppf<0x124>(x); x += dppf<0x128>(x); return x; }
DI float reduce8(float x) { x += dppf<0xB1>(x); x += dppf<0x4E>(x); x += dppf<0x141>(x); return x; }
DI float wave_sum(float x) { for (int o = 32; o >= 1; o >>= 1) x += __shfl_xor(x, o); return x; }
DI float silu(float v) { return v / (1.f + __expf(-v)); }
DI float fexp2(float x) { return __builtin_amdgcn_exp2f(x); }


#define XB_TMO      128
#define XB_XCNT(j)  (256  + 64 * (j))
#define XB_XSUB(j)  (1280 + 64 * (j))
#define XB_XGEN(j)  (2304 + 64 * (j))
#define XB_TOP      3328
#define XB_TOPGEN   3392
#define XCD_BAR_WORDS 3456
#define XB_SPIN_CAP (1u << 20)
#define LAS __attribute__((address_space(3)))
DI unsigned xb_ld(unsigned* p) { return __hip_atomic_load(p, __ATOMIC_RELAXED, __HIP_MEMORY_SCOPE_AGENT); }
DI unsigned xb_add(unsigned* p, unsigned v) { return __hip_atomic_fetch_add(p, v, __ATOMIC_RELAXED, __HIP_MEMORY_SCOPE_AGENT); }
DI unsigned xb_xcc_id() { return (unsigned)__builtin_amdgcn_s_getreg((3 << 11) | 20) & 0xFu; }
#define XB_SPIN(cond, bar) do { unsigned _sp = 0; while (cond) { __builtin_amdgcn_s_sleep(1); \
    if ((++_sp & 255u) == 0u) { if (xb_ld(&(bar)[XB_TMO])) break; if (_sp > XB_SPIN_CAP) { atomicAdd(&(bar)[XB_TMO], 1u); break; } } } } while (0)
struct XcdBarrier { unsigned* bar; unsigned x; volatile LAS unsigned* st; };
DI XcdBarrier xcd_barrier_post(unsigned* bar, volatile LAS unsigned* st) {
  XcdBarrier b; b.bar = bar; b.x = xb_xcc_id(); b.st = st;
  if (threadIdx.x == 0) st[2] = xb_add(&bar[XB_XCNT(b.x)], 1u);
  return b;
}
DI void xcd_barrier_complete(unsigned* bar, unsigned x, unsigned& nloc, unsigned& nx) {
  const unsigned G = gridDim.x * gridDim.y * gridDim.z;
  unsigned sum, cnt, mine, sp = 0u;
  for (;;) {
    sum = 0u; cnt = 0u; mine = 0u;
#pragma unroll
    for (unsigned j = 0; j < 16; ++j) { const unsigned c = xb_ld(&bar[XB_XCNT(j)]); sum += c; cnt += (c > 0u) ? 1u : 0u; mine = (j == x) ? c : mine; }
    if (sum == G) break;
    __builtin_amdgcn_s_sleep(1);
    if ((++sp & 255u) == 0u) { if (xb_ld(&bar[XB_TMO])) break; if (sp > XB_SPIN_CAP) { atomicAdd(&bar[XB_TMO], 1u); break; } }
  }
  nloc = mine > 0u ? mine : 1u; nx = cnt > 0u ? cnt : 1u;
}
DI void xcd_barrier(const XcdBarrier& b) {
  asm volatile("s_waitcnt vmcnt(0)" ::: "memory");
  __syncthreads();
  if (threadIdx.x == 0) {
    unsigned* bar = b.bar;
    __builtin_amdgcn_s_waitcnt(0);
    unsigned nloc = b.st[0], nx = b.st[1];
    if (nloc == 0u) { xcd_barrier_complete(bar, b.x, nloc, nx); b.st[0] = nloc; b.st[1] = nx; }
    const unsigned old = xb_add(&bar[XB_XSUB(b.x)], 1u);
    const unsigned gen = old / nloc;
    if (old + 1u == (gen + 1u) * nloc) {
      __builtin_amdgcn_fence(__ATOMIC_RELEASE, "agent");
      asm volatile("s_waitcnt vmcnt(0)" ::: "memory");
      const unsigned og = xb_add(&bar[XB_TOP], 1u);
      const unsigned tg = og / nx;
      if (og + 1u == (tg + 1u) * nx) xb_add(&bar[XB_TOPGEN], 1u);
      else XB_SPIN(xb_ld(&bar[XB_TOPGEN]) == tg, bar);
      __builtin_amdgcn_fence(__ATOMIC_ACQUIRE, "agent");
      xb_add(&bar[XB_XGEN(b.x)], 1u);
      asm volatile("s_waitcnt vmcnt(0)" ::: "memory");
    } else {
      XB_SPIN(xb_ld(&bar[XB_XGEN(b.x)]) == gen, bar);
      __builtin_amdgcn_fence(__ATOMIC_ACQUIRE, "agent");
      asm volatile("s_waitcnt vmcnt(0)" ::: "memory");
    }
  }
  __syncthreads();
}

#define DPP_ADD(name, ctrl) DI float name(float x) { float r; asm("s_nop 1\n\tv_add_f32_dpp %0, %1, %1 " ctrl " row_mask:0xf bank_mask:0xf" : "=v"(r) : "v"(x)); return r; }
DPP_ADD(dpa_x1, "quad_perm:[1,0,3,2]")
DPP_ADD(dpa_x2, "quad_perm:[2,3,0,1]")
DPP_ADD(dpa_hm, "row_half_mirror")
DPP_ADD(dpa_r4, "row_ror:4")
DPP_ADD(dpa_r8, "row_ror:8")
template <int LPR> DI float red_lpr(float x) {
  x = dpa_x1(x); x = dpa_x2(x);
  if (LPR == 8) x = dpa_hm(x); else { x = dpa_r4(x); x = dpa_r8(x); }
  return x;
}

DI void phase_prep(const Params& p, char* smem, int vb, int nvb) {
  const int tid = threadIdx.x;
  float* tile = (float*)smem;
  float* sc = (float*)smem;
  float* part = sc + 5120;
  for (int u = vb; u < 2048 + 384; u += nvb) {
    if (u < 2048) {
      int ti = u; const float* W; u16* Wt; int N;
      if (ti < 896) { W = p.w_in_even; Wt = (u16*)(p.ws + OFF_WT0); N = 3584; }
      else if (ti < 1152) { ti -= 896; W = p.w_out_even; Wt = (u16*)(p.ws + OFF_WT1); N = 1024; }
      else if (ti < 1792) { ti -= 1152; W = p.w_in_odd; Wt = (u16*)(p.ws + OFF_WT2); N = 2560; }
      else { ti -= 1792; W = p.w_out_odd; Wt = (u16*)(p.ws + OFF_WT3); N = 1024; }
      const int ntn = N >> 6;
      const int kt = ti / ntn, nt = ti - kt * ntn;
#pragma unroll
      for (int ps = 0; ps < 4; ++ps) {
        const int row = (tid >> 4) + 16 * ps, c4 = (tid & 15) * 4;
        const f32x4 v = *(const f32x4*)(W + (size_t)(kt * 64 + row) * N + nt * 64 + c4);
        tile[row * 65 + c4 + 0] = v[0]; tile[row * 65 + c4 + 1] = v[1]; tile[row * 65 + c4 + 2] = v[2]; tile[row * 65 + c4 + 3] = v[3];
      }
      __syncthreads();
      const int n = tid >> 2, kq = (tid & 3) * 16;
      unsigned o[8];
#pragma unroll
      for (int j = 0; j < 8; ++j) o[j] = pk2(tile[(kq + 2 * j) * 65 + n], tile[(kq + 2 * j + 1) * 65 + n]);
      u32x4* dst = (u32x4*)(Wt + (size_t)(nt * 64 + n) * 1024 + kt * 64 + kq);
      dst[0] = mk4(o[0], o[1], o[2], o[3]);
      dst[1] = mk4(o[4], o[5], o[6], o[7]);
      __syncthreads();
    } else {
      const int u2 = u - 2048;
      const int l = u2 / 192, cb = u2 - l * 192;
      for (int idx = tid; idx < 5120; idx += 256) {
        const int s = idx >> 10, k = idx & 1023;
        const float v = (s < 4) ? p.c[s * 1024 + k] : p.c_ctx[k];
        sc[idx] = v / (1.f + expf(-v));
      }
      __syncthreads();
      const int col = tid & 15, kg = tid >> 4;
      float acc[5] = {0.f, 0.f, 0.f, 0.f, 0.f};
      const float* wp = p.w_mod + ((size_t)l * 1024 + kg * 64) * 3072 + cb * 16 + col;
#pragma unroll 16
      for (int k = 0; k < 64; ++k) {
        const float wv = wp[(size_t)k * 3072];
#pragma unroll
        for (int s = 0; s < 5; ++s) acc[s] += sc[s * 1024 + kg * 64 + k] * wv;
      }
#pragma unroll
      for (int s = 0; s < 5; ++s) part[(kg * 5 + s) * 16 + col] = acc[s];
      __syncthreads();
      if (tid < 80) {
        const int s = tid >> 4, cc = tid & 15;
        float a = 0.f;
        for (int g = 0; g < 16; ++g) a += part[(g * 5 + s) * 16 + cc];
        float* MOD = (float*)(p.ws + OFF_MOD);
        MOD[(l * 5 + s) * 3072 + cb * 16 + cc] = a + p.b_mod[l * 3072 + cb * 16 + cc];
      }
      __syncthreads();
    }
  }
}

DI void phase_prenorm0(const Params& p, int vb, int nvb) {
  const int tid = threadIdx.x, lane = tid & 63, w = tid >> 6;
  const float* MOD = (const float*)(p.ws + OFF_MOD);
  u16* HX = (u16*)(p.ws + OFF_HX);
  for (int u = vb; u < MROWS / 4; u += nvb) {
    const int rowg = u * 4 + w;
    const int b = rowg / TT, tok = rowg - b * TT;
    const bool lat = tok < 4096;
    const float* src = lat ? p.x + ((size_t)b * 4096 + tok) * 1024 : p.ctx + ((size_t)b * 256 + (tok - 4096)) * 1024;
    const float* mod = MOD + (0 * 5 + (lat ? b : 4)) * 3072;
    f32x4 v[4]; float ss = 0.f;
#pragma unroll
    for (int j = 0; j < 4; ++j) { v[j] = __builtin_nontemporal_load((const f32x4*)(src + j * 256 + lane * 4)); ss += v[j][0] * v[j][0] + v[j][1] * v[j][1] + v[j][2] * v[j][2] + v[j][3] * v[j][3]; }
    ss = wave_sum(ss);
    const float rinv = rsqrtf(ss * (1.f / 1024.f) + 1e-6f);
#pragma unroll
    for (int j = 0; j < 4; ++j) {
      const int col = j * 256 + lane * 4;
      const f32x4 g = *(const f32x4*)(p.g_pre + col), sh = *(const f32x4*)(mod + col), scv = *(const f32x4*)(mod + 1024 + col);
      float hv[4];
#pragma unroll
      for (int e = 0; e < 4; ++e) hv[e] = (v[j][e] * rinv * g[e]) * (1.f + scv[e]) + sh[e];
      *(u32x2*)(HX + (size_t)rowg * 1024 + col) = mk2(pk2(hv[0], hv[1]), pk2(hv[2], hv[3]));
    }
  }
}

template <int MODE>
DI void gemm_phase(const Params& p, char* smem, int vb, int nvb, const u16* __restrict__ Wt, const u16* __restrict__ X, int NT) {
  u16* As = (u16*)smem;
  u16* Bs = As + 2 * 128 * 72;
  const int tid = threadIdx.x, lane = tid & 63, w = tid >> 6, r = lane & 31, h = lane >> 5;
  const int wn = w & 1, wt = w >> 1;
  const int total = 136 * NT;
  const int NB4 = NT >> 2;
  for (int u = vb; u < total; u += nvb) {
    const int blk = u >> 5, wi = u & 31;
    const int mbk = blk / NB4, nbk = blk - mbk * NB4;
    const int mt = mbk * 8 + (wi >> 2), nt = nbk * 4 + (wi & 3);
    const bool ctx_tile = (mt % 34) >= 32;
    if (MODE == 2 && ctx_tile && (nt < 8 || nt >= 12)) continue;
    if (MODE == 3 && ctx_tile) continue;
    const u16* Wg = Wt + (size_t)(nt * 128) * 1024;
    const u16* Xg = X + (size_t)(mt * 128) * 1024;
    f32x16 acc[2][2];
#pragma unroll
    for (int a = 0; a < 2; ++a)
#pragma unroll
      for (int bq = 0; bq < 2; ++bq)
#pragma unroll
        for (int i = 0; i < 16; ++i) acc[a][bq][i] = 0.f;
    u32x4 ra[4], rb[4];
#define GEMM_LOAD(KT)                                                                                     \
    {                                                                                                     \
      _Pragma("unroll") for (int j = 0; j < 4; ++j) {                                                     \
        const int cidx = tid + 256 * j, row = cidx >> 3, part = cidx & 7;                                 \
        ra[j] = *(const u32x4*)(Wg + (size_t)row * 1024 + (KT) * 64 + part * 8);                          \
        rb[j] = *(const u32x4*)(Xg + (size_t)row * 1024 + (KT) * 64 + part * 8);                          \
      }                                                                                                   \
    }
#define GEMM_STORE(BUF)                                                                                   \
    {                                                                                                     \
      _Pragma("unroll") for (int j = 0; j < 4; ++j) {                                                     \
        const int cidx = tid + 256 * j, row = cidx >> 3, part = cidx & 7;                                 \
        *(u32x4*)(As + (BUF) * 9216 + row * 72 + part * 8) = ra[j];                                      \
        *(u32x4*)(Bs + (BUF) * 9216 + row * 72 + part * 8) = rb[j];                                      \
      }                                                                                                   \
    }
    GEMM_LOAD(0)
    GEMM_STORE(0)
    GEMM_LOAD(1)
    __syncthreads();
    for (int kt = 0; kt < 16; ++kt) {
      const int cbuf = kt & 1;
      const u16* Ac = As + cbuf * 9216;
      const u16* Bc = Bs + cbuf * 9216;
#pragma unroll
      for (int ks = 0; ks < 4; ++ks) {
        const bf16x8 a0 = *(const bf16x8*)(Ac + (wn * 64 + r) * 72 + ks * 16 + h * 8);
        const bf16x8 a1 = *(const bf16x8*)(Ac + (wn * 64 + 32 + r) * 72 + ks * 16 + h * 8);
        const bf16x8 b0 = *(const bf16x8*)(Bc + (wt * 64 + r) * 72 + ks * 16 + h * 8);
        const bf16x8 b1 = *(const bf16x8*)(Bc + (wt * 64 + 32 + r) * 72 + ks * 16 + h * 8);
        acc[0][0] = MFMA32(a0, b0, acc[0][0]);
        acc[0][1] = MFMA32(a0, b1, acc[0][1]);
        acc[1][0] = MFMA32(a1, b0, acc[1][0]);
        acc[1][1] = MFMA32(a1, b1, acc[1][1]);
      }
      __builtin_amdgcn_sched_barrier(0);
      if (kt + 1 < 16) GEMM_STORE(cbuf ^ 1)
      if (kt + 2 < 16) GEMM_LOAD(kt + 2)
      __syncthreads();
    }
#undef GEMM_LOAD
#undef GEMM_STORE
    const int nbase = nt * 128 + wn * 64;
    if (MODE == 1 || MODE == 3) {
      u16* Y = (u16*)(p.ws + OFF_Y);
#pragma unroll
      for (int tb = 0; tb < 2; ++tb) {
        const int rowg = mt * 128 + wt * 64 + tb * 32 + r;
#pragma unroll
        for (int nb = 0; nb < 2; ++nb)
#pragma unroll
          for (int ig = 0; ig < 4; ++ig) {
            *(u32x2*)(Y + (size_t)rowg * 1024 + nbase + nb * 32 + 8 * ig + 4 * h) =
                mk2(pk2(acc[nb][tb][4 * ig], acc[nb][tb][4 * ig + 1]), pk2(acc[nb][tb][4 * ig + 2], acc[nb][tb][4 * ig + 3]));
          }
      }
    } else {
      const int seg = nbase >> 6;
      int kind, hidx, QP, Gn, gateoff; const float* gain;
      if (MODE == 0) {
        QP = 512; Gn = 2;
        if (seg < 8) { kind = 0; hidx = seg; gain = p.qn_a; }
        else if (seg < 10) { kind = 1; hidx = seg - 8; gain = p.kn_a; }
        else if (seg < 12) { kind = 2; hidx = seg - 10; gain = nullptr; }
        else if (seg < 40) { kind = 3; hidx = 0; gain = nullptr; }
        else { kind = 4; hidx = 0; gain = nullptr; }
        gateoff = 2560;
      } else {
        QP = 1024; Gn = 4;
        if (seg < 16) { kind = 0; hidx = seg; gain = p.qn_c; }
        else if (seg < 20) { kind = 1; hidx = seg - 16; gain = p.kn_c; }
        else if (seg < 24) { kind = 2; hidx = seg - 20; gain = nullptr; }
        else { kind = 4; hidx = 0; gain = nullptr; }
        gateoff = 1536;
      }
      u16* Q = (u16*)(p.ws + OFF_Q);
      u16* KB = (u16*)(p.ws + OFF_KB);
      u16* VT = (u16*)(p.ws + OFF_VT);
      u16* PB = (u16*)(p.ws + OFF_PB);
      u16* G = (u16*)(p.ws + OFF_G);
#pragma unroll
      for (int tb = 0; tb < 2; ++tb) {
        const int rowg = mt * 128 + wt * 64 + tb * 32 + r;
        const int b = rowg / TT, tok = rowg - b * TT;
        const bool lat = tok < 4096;
        if (kind <= 1) {
          float ss = 0.f;
#pragma unroll
          for (int nb = 0; nb < 2; ++nb)
#pragma unroll
            for (int i = 0; i < 16; ++i) ss += acc[nb][tb][i] * acc[nb][tb][i];
          ss += __shfl_xor(ss, 32);
          const float rinv = rsqrtf(ss * (1.f / 64.f) + 1e-6f);
          const float prow = (float)(tok >> 6), pcol = (float)(tok & 63);
          const float osc = (kind == 0) ? 0.125f * 1.4426950408889634f : 1.f;
#pragma unroll
          for (int nb = 0; nb < 2; ++nb)
#pragma unroll
            for (int ig = 0; ig < 4; ++ig) {
              const int nin = nb * 32 + 8 * ig + 4 * h;
              const f32x4 gv = *(const f32x4*)(gain + nin);
              float xv[4];
#pragma unroll
              for (int e = 0; e < 4; ++e) xv[e] = acc[nb][tb][4 * ig + e] * rinv * gv[e];
              if (lat) {
#pragma unroll
                for (int pr = 0; pr < 2; ++pr) {
                  const int j = 4 * ig + 2 * h + pr;
                  const float ang = (nb == 0 ? prow : pcol) * exp2f(-(float)j * 0.8304820237218405f);
                  const float cs = __cosf(ang), sn = __sinf(ang);
                  const float x1 = xv[2 * pr], x2 = xv[2 * pr + 1];
                  xv[2 * pr] = x1 * cs - x2 * sn;
                  xv[2 * pr + 1] = x1 * sn + x2 * cs;
                }
              }
              const u32x2 o = mk2(pk2(xv[0] * osc, xv[1] * osc), pk2(xv[2] * osc, xv[3] * osc));
              if (kind == 0) *(u32x2*)(Q + (size_t)rowg * QP + hidx * 64 + nin) = o;
              else *(u32x2*)(KB + ((size_t)(b * Gn + hidx) * TT + tok) * 64 + nin) = o;
            }
        } else if (kind == 2) {
#pragma unroll
          for (int nb = 0; nb < 2; ++nb)
#pragma unroll
            for (int i = 0; i < 16; ++i) {
              const int dd = nb * 32 + (i & 3) + 8 * (i >> 2) + 4 * h;
              VT[((size_t)(b * Gn + hidx) * 64 + dd) * TT + tok] = bf1(acc[nb][tb][i]);
            }
        } else if (kind == 3) {
#pragma unroll
          for (int nb = 0; nb < 2; ++nb)
#pragma unroll
            for (int ig = 0; ig < 4; ++ig)
              *(u32x2*)(PB + (size_t)rowg * 1792 + (nbase - 768) + nb * 32 + 8 * ig + 4 * h) =
                  mk2(pk2(acc[nb][tb][4 * ig], acc[nb][tb][4 * ig + 1]), pk2(acc[nb][tb][4 * ig + 2], acc[nb][tb][4 * ig + 3]));
        } else {
#pragma unroll
          for (int nb = 0; nb < 2; ++nb)
#pragma unroll
            for (int ig = 0; ig < 4; ++ig)
              *(u32x2*)(G + (size_t)rowg * 1024 + (nbase - gateoff) + nb * 32 + 8 * ig + 4 * h) =
                  mk2(pk2(silu(acc[nb][tb][4 * ig]), silu(acc[nb][tb][4 * ig + 1])), pk2(silu(acc[nb][tb][4 * ig + 2]), silu(acc[nb][tb][4 * ig + 3])));
        }
      }
    }
  }
}

DI void attn_block(const Params& p, char* smem, int QP, int Gn, int b, int head, int qtok0,
                   int t_first, int n_first, int t_second, int n_second, bool win, bool has_sink, float sink2) {
  u16* Ks = (u16*)smem;
  u16* Vs = Ks + 2 * 4608;
  const u16* Q = (const u16*)(p.ws + OFF_Q);
  const u16* G = (const u16*)(p.ws + OFF_G);
  u16* A2 = (u16*)(p.ws + OFF_HX);
  const int tid = threadIdx.x, lane = tid & 63, w = tid >> 6, r = lane & 31, h = lane >> 5;
  const int g = head >> 2;
  const u16* Kg = (const u16*)(p.ws + OFF_KB) + (size_t)(b * Gn + g) * TT * 64;
  const u16* Vg = (const u16*)(p.ws + OFF_VT) + (size_t)(b * Gn + g) * 64 * TT;
  const int qtok = qtok0 + w * 32 + r;
  const size_t qrow = (size_t)b * TT + qtok;
  bf16x8 qf[4];
#pragma unroll
  for (int ks = 0; ks < 4; ++ks) qf[ks] = *(const bf16x8*)(Q + qrow * QP + head * 64 + ks * 16 + h * 8);
  f32x16 o[2];
#pragma unroll
  for (int db = 0; db < 2; ++db)
#pragma unroll
    for (int i = 0; i < 16; ++i) o[db][i] = 0.f;
  float m = -INFINITY, l = 0.f;
  const int ntot = n_first + n_second;
  u32x4 rk[2], rv[2];
#define ATT_TILE(IT) (((IT) < n_first) ? (t_first + (IT)) : (t_second + (IT) - n_first))
#define ATT_LOAD(TILE)                                                                                   \
  {                                                                                                      \
    _Pragma("unroll") for (int j = 0; j < 2; ++j) {                                                      \
      const int cidx = tid + 256 * j, row = cidx >> 3, part = cidx & 7;                                  \
      rk[j] = *(const u32x4*)(Kg + (size_t)((TILE) * 64 + row) * 64 + part * 8);                         \
      rv[j] = *(const u32x4*)(Vg + (size_t)row * TT + (TILE) * 64 + part * 8);                           \
    }                                                                                                    \
  }
#define ATT_STORE(BUF)                                                                                   \
  {                                                                                                      \
    _Pragma("unroll") for (int j = 0; j < 2; ++j) {                                                      \
      const int cidx = tid + 256 * j, row = cidx >> 3, part = cidx & 7;                                  \
      *(u32x4*)(Ks + (BUF) * 4608 + row * 72 + part * 8) = rk[j];                                        \
      *(u32x4*)(Vs + (BUF) * 4608 + row * 72 + part * 8) = rv[j];                                        \
    }                                                                                                    \
  }
  __syncthreads();
  ATT_LOAD(ATT_TILE(0))
  ATT_STORE(0)
  if (ntot > 1) ATT_LOAD(ATT_TILE(1))
  __syncthreads();
  for (int it = 0; it < ntot; ++it) {
    const int tile = ATT_TILE(it);
    const int cbuf = it & 1;
    const u16* Kc = Ks + cbuf * 4608;
    const u16* Vc = Vs + cbuf * 4608;
    const int qw0 = qtok0 + w * 32;
    const bool live = !win || tile >= 64 || (tile * 64 <= qw0 + 31 + 128 && tile * 64 + 63 >= qw0 - 128);
    if (live) {
    f32x16 s[2];
#pragma unroll
    for (int kb = 0; kb < 2; ++kb) {
#pragma unroll
      for (int i = 0; i < 16; ++i) s[kb][i] = 0.f;
#pragma unroll
      for (int ks = 0; ks < 4; ++ks) {
        const bf16x8 a = *(const bf16x8*)(Kc + (kb * 32 + r) * 72 + ks * 16 + h * 8);
        s[kb] = MFMA32(a, qf[ks], s[kb]);
      }
    }
    if (win && tile < 64) {
#pragma unroll
      for (int kb = 0; kb < 2; ++kb)
#pragma unroll
        for (int i = 0; i < 16; ++i) {
          const int key = tile * 64 + kb * 32 + (i & 3) + 8 * (i >> 2) + 4 * h;
          const int dl = key - qtok;
          if (dl > 128 || dl < -128) s[kb][i] = -INFINITY;
        }
    }
    float mx = -INFINITY;
#pragma unroll
    for (int kb = 0; kb < 2; ++kb)
#pragma unroll
      for (int i = 0; i < 16; ++i) mx = fmaxf(mx, s[kb][i]);
    mx = fmaxf(mx, __shfl_xor(mx, 32));
    float alpha = 1.f;
    if (!__all(mx - m <= 8.f)) {
      const float mn = fmaxf(m, mx);
      alpha = fexp2(m - mn);
      m = mn;
#pragma unroll
      for (int db = 0; db < 2; ++db)
#pragma unroll
        for (int i = 0; i < 16; ++i) o[db][i] *= alpha;
    }
    float ps = 0.f;
#pragma unroll
    for (int kb = 0; kb < 2; ++kb)
#pragma unroll
      for (int i = 0; i < 16; ++i) { s[kb][i] = fexp2(s[kb][i] - m); ps += s[kb][i]; }
    l = l * alpha + ps;
#pragma unroll
    for (int kb = 0; kb < 2; ++kb)
#pragma unroll
      for (int st = 0; st < 2; ++st) {
        const unsigned p0 = pk2(s[kb][8 * st + 0], s[kb][8 * st + 1]), p1 = pk2(s[kb][8 * st + 2], s[kb][8 * st + 3]);
        const unsigned p2 = pk2(s[kb][8 * st + 4], s[kb][8 * st + 5]), p3 = pk2(s[kb][8 * st + 6], s[kb][8 * st + 7]);
        const u32x4 pu = mk4(p0, p1, p2, p3);
        const bf16x8 pf = __builtin_bit_cast(bf16x8, pu);
#pragma unroll
        for (int db = 0; db < 2; ++db) {
          const s16x4 lo = *(const s16x4*)(Vc + (db * 32 + r) * 72 + kb * 32 + 16 * st + 4 * h);
          const s16x4 hi = *(const s16x4*)(Vc + (db * 32 + r) * 72 + kb * 32 + 16 * st + 8 + 4 * h);
          const bf16x8 vf = __builtin_shufflevector(lo, hi, 0, 1, 2, 3, 4, 5, 6, 7);
          o[db] = MFMA32(vf, pf, o[db]);
        }
      }
    }
    __builtin_amdgcn_sched_barrier(0);
    if (it + 1 < ntot) ATT_STORE(cbuf ^ 1)
    if (it + 2 < ntot) ATT_LOAD(ATT_TILE(it + 2))
    __syncthreads();
  }
#undef ATT_TILE
#undef ATT_LOAD
#undef ATT_STORE
  l += __shfl_xor(l, 32);
  if (has_sink) {
    const float mn = fmaxf(m, sink2);
    const float alpha = fexp2(m - mn);
    l = l * alpha + fexp2(sink2 - mn);
#pragma unroll
    for (int db = 0; db < 2; ++db)
#pragma unroll
      for (int i = 0; i < 16; ++i) o[db][i] *= alpha;
  }
  const float inv = 1.f / l;
#pragma unroll
  for (int db = 0; db < 2; ++db)
#pragma unroll
    for (int ig = 0; ig < 4; ++ig) {
      const int dd = db * 32 + 8 * ig + 4 * h;
      const u32x2 gt = *(const u32x2*)(G + qrow * 1024 + head * 64 + dd);
      const float v0 = o[db][4 * ig] * inv * bf_lo(gt.x), v1 = o[db][4 * ig + 1] * inv * bf_hi(gt.x);
      const float v2 = o[db][4 * ig + 2] * inv * bf_lo(gt.y), v3 = o[db][4 * ig + 3] * inv * bf_hi(gt.y);
      *(u32x2*)(A2 + qrow * 1024 + head * 64 + dd) = mk2(pk2(v0, v1), pk2(v2, v3));
    }
}

DI int scan_tok(int s, int d) {
  if (s < 256) return 4096 + (d ? 255 - s : s);
  const int i = s - 256;
  return d ? 4095 - i : i;
}

template <class T> DI T ldgo(const void* base, unsigned byteoff) { return *(const T*)((const char*)base + byteoff); }
DI int scan_segoff(int sg, int d, int h) { return sg < 3 ? sg * 512 + h * 64 : 1536 + (sg - 3) * 128 + d * 64; }
DI float frcp(float x) { return __builtin_amdgcn_rcpf(x); }
DI float tanh_fast(float x) { const float e = __expf(2.f * x); return 1.f - 2.f * frcp(e + 1.f); }

#define GAS __attribute__((address_space(1)))
typedef GAS unsigned long long gu64;
typedef GAS unsigned gu32;
static constexpr int RING = 21;
static constexpr int SLOT_F = 3200;
DI int rec_voff(int vec) { return vec * 64 + (vec >= 3 ? 64 : 0); }
static constexpr size_t OFF_RING = OFF_Q + 17825792;
DI unsigned flag_ld(unsigned* f) { return __hip_atomic_load(f, __ATOMIC_RELAXED, __HIP_MEMORY_SCOPE_AGENT); }
DI void flag_st(unsigned* f, unsigned v) { __hip_atomic_store(f, v, __ATOMIC_RELAXED, __HIP_MEMORY_SCOPE_AGENT); }
#define FLAG_PROD(chain, par) ((unsigned*)(p.ws + OFF_FLAGS) + ((chain) * 2 + (par)) * 64)
#define FLAG_CONS(chain, sp) ((unsigned*)(p.ws + OFF_FLAGS) + (128 + (chain) * 4 + (sp)) * 64)
#define FLAG_TMO ((unsigned*)(p.ws + OFF_FLAGS) + 384 * 64)
#define PC_WAIT(cond) do { unsigned _sp = 0; while (cond) { __builtin_amdgcn_s_sleep(1); \
    if ((++_sp & 1023u) == 0u) { if (flag_ld(FLAG_TMO)) break; if (_sp > (1u << 22)) { flag_st(FLAG_TMO, 1u); break; } } } } while (0)

#ifndef NPROD
#define NPROD 2
#endif
DI void scan_producer(const Params& p, char* smem, int chain, int par) {
  __builtin_amdgcn_s_setprio(2);
  const int tid = threadIdx.x, lane = tid & 63, w = tid >> 6;
  const int d = chain >> 5, b = (chain >> 3) & 3, h = chain & 7;
  float* REC = (float*)smem;
  float* RSs = REC + 8 * 768;
  float* KSs = RSs + 1024;
  float* INVN = KSs + 1024;
  float* SCP = INVN + 16;
  float* BONP = SCP + 128;
  float* CST = BONP + 64;
  u16* ZW = (u16*)(CST + 768);
  u16* ZA = ZW + 16 * 72;
  u16* RAW = ZA + 16 * 72;
  const u16* PB = (const u16*)(p.ws + OFF_PB);
  u16* VSH = (u16*)(p.ws + OFF_VSH);
  float* BONS = (float*)(p.ws + OFF_BONS);
  float* ring = (float*)(p.ws + OFF_RING) + (size_t)chain * RING * SLOT_F;

  if (tid < 64) {
    const unsigned hc = (unsigned)(h * 64 + tid) * 4u, dhc = (unsigned)(d * 512 + h * 64 + tid) * 4u;
#pragma unroll
    for (int sg = 0; sg < 5; ++sg) CST[sg * 64 + tid] = ldgo<float>(p.mu_b, (unsigned)(scan_segoff(sg, d, h) + tid) * 4u);
    CST[320 + tid] = ldgo<float>(p.kk_b, hc);
    CST[512 + tid] = ldgo<float>(p.w0_b, dhc);
    CST[576 + tid] = ldgo<float>(p.a0_b, dhc);
    CST[640 + tid] = ldgo<float>(p.ka_b, hc);
    CST[704 + tid] = ldgo<float>(p.rk_b, hc);
  }
  const int t1 = tid >> 4, q = tid & 15, c4 = q * 4;
  const int hhi = tid / 80, hsg = (tid % 80) >> 4;
  const int c2 = 16 * w + (lane & 15), tg = lane >> 4;
  bf16x8 bw[2], ba[2];
#pragma unroll
  for (int ks = 0; ks < 2; ++ks) {
    unsigned uw[4], ua[4];
#pragma unroll
    for (int e2 = 0; e2 < 4; ++e2) {
      const int j0 = tg * 8 + 32 * ks + 2 * e2;
      const unsigned o0 = (unsigned)((d * 64 + j0) * 512 + h * 64 + c2) * 4u;
      uw[e2] = pk2(ldgo<float>(p.w2_b, o0), ldgo<float>(p.w2_b, o0 + 2048u));
      ua[e2] = pk2(ldgo<float>(p.a2_b, o0), ldgo<float>(p.a2_b, o0 + 2048u));
    }
    bw[ks] = __builtin_bit_cast(bf16x8, mk4(uw[0], uw[1], uw[2], uw[3]));
    ba[ks] = __builtin_bit_cast(bf16x8, mk4(ua[0], ua[1], ua[2], ua[3]));
  }
  u32x2 pr[5], ph = mk2(0u, 0u);
  const unsigned pbase = (unsigned)(b * TT) * 3584u;
#define SCAN_LOAD(CH)                                                                                                   \
  {                                                                                                                     \
    const unsigned ro_ = pbase + (unsigned)scan_tok((CH) * 16 + t1, d) * 3584u + (unsigned)c4 * 2u;                     \
    _Pragma("unroll") for (int sg = 0; sg < 5; ++sg) pr[sg] = ldgo<u32x2>(PB, ro_ + (unsigned)scan_segoff(sg, d, h) * 2u); \
    if (tid < 160) {                                                                                                    \
      const int sh_ = hhi ? (CH) * 16 + 16 : (CH) * 16 - 1;                                                             \
      const bool valid_ = hhi ? (sh_ != 256 && sh_ != 4352) : (sh_ != -1 && sh_ != 255);                               \
      ph = mk2(0u, 0u);                                                                                                 \
      if (valid_) ph = ldgo<u32x2>(PB, pbase + (unsigned)scan_tok(sh_, d) * 3584u + (unsigned)(scan_segoff(hsg, d, h) + c4) * 2u); \
    }                                                                                                                   \
  }
  SCAN_LOAD(par)
  int pub = -1;
  for (int ch = par; ch < 272; ch += NPROD) {
#pragma unroll
    for (int sg = 0; sg < 5; ++sg) *(u32x2*)(RAW + (t1 + 1) * 320 + sg * 64 + c4) = pr[sg];
    if (tid < 160) *(u32x2*)(RAW + (hhi * 17) * 320 + hsg * 64 + c4) = ph;
    asm volatile("s_waitcnt vmcnt(0)" ::: "memory");
    __syncthreads();
    if (tid == 0 && pub >= 0) flag_st(FLAG_PROD(chain, par), (unsigned)(pub + 1));
    unsigned cseen = 0xffffffffu;
    if (ch >= RING && tid < 4) cseen = flag_ld(FLAG_CONS(chain, tid));
    const int tok = scan_tok(ch * 16 + t1, d);
    {
      float sv[5][4];
#pragma unroll
      for (int sg = 0; sg < 5; ++sg) {
        const u32x2 cu = *(const u32x2*)(RAW + (t1 + 1) * 320 + sg * 64 + c4);
        const u32x2 pu = *(const u32x2*)(RAW + t1 * 320 + sg * 64 + c4);
        const u32x2 nu = *(const u32x2*)(RAW + (t1 + 2) * 320 + sg * 64 + c4);
        const f32x4 mu = *(const f32x4*)(CST + sg * 64 + c4);
        const float c0 = bf_lo(cu.x), c1 = bf_hi(cu.x), c2v = bf_lo(cu.y), c3 = bf_hi(cu.y);
        const float n0 = 0.5f * (bf_lo(pu.x) + bf_lo(nu.x)), n1 = 0.5f * (bf_hi(pu.x) + bf_hi(nu.x));
        const float n2 = 0.5f * (bf_lo(pu.y) + bf_lo(nu.y)), n3 = 0.5f * (bf_hi(pu.y) + bf_hi(nu.y));
        sv[sg][0] = c0 + mu[0] * (n0 - c0); sv[sg][1] = c1 + mu[1] * (n1 - c1);
        sv[sg][2] = c2v + mu[2] * (n2 - c2v); sv[sg][3] = c3 + mu[3] * (n3 - c3);
      }
      *(f32x4*)(RSs + t1 * 64 + c4) = (f32x4){sv[0][0], sv[0][1], sv[0][2], sv[0][3]};
      *(f32x4*)(KSs + t1 * 64 + c4) = (f32x4){sv[1][0], sv[1][1], sv[1][2], sv[1][3]};
      {
        float* vp = REC + (t1 >> 1) * 768 + 576 + c4 * 2 + (t1 & 1);
        vp[0] = sv[2][0]; vp[2] = sv[2][1]; vp[4] = sv[2][2]; vp[6] = sv[2][3];
      }
      if (d == 0) *(u32x2*)(VSH + (size_t)(b * TT + tok) * 512 + h * 64 + c4) = mk2(pk2(sv[2][0], sv[2][1]), pk2(sv[2][2], sv[2][3]));
      *(u32x2*)(ZW + t1 * 72 + c4) = mk2(pk2(tanh_fast(sv[3][0]), tanh_fast(sv[3][1])), pk2(tanh_fast(sv[3][2]), tanh_fast(sv[3][3])));
      *(u32x2*)(ZA + t1 * 72 + c4) = mk2(pk2(sv[4][0], sv[4][1]), pk2(sv[4][2], sv[4][3]));
      const f32x4 kkc1 = *(const f32x4*)(CST + 320 + c4);
      float ssq = 0.f;
#pragma unroll
      for (int e = 0; e < 4; ++e) { const float kq = sv[1][e] * kkc1[e]; ssq += kq * kq; }
      ssq = reduce16(ssq);
      if (q == 0) INVN[t1] = frcp(fmaxf(sqrtf(ssq), 1e-12f));
    }
    if (ch + NPROD < 272) SCAN_LOAD(ch + NPROD)
    __syncthreads();
    {
      const bf16x8 az0 = *(const bf16x8*)(ZW + (lane & 15) * 72 + tg * 8), az1 = *(const bf16x8*)(ZW + (lane & 15) * 72 + tg * 8 + 32);
      const bf16x8 aa0 = *(const bf16x8*)(ZA + (lane & 15) * 72 + tg * 8), aa1 = *(const bf16x8*)(ZA + (lane & 15) * 72 + tg * 8 + 32);
      f32x4 xw = {0.f, 0.f, 0.f, 0.f}, xa = {0.f, 0.f, 0.f, 0.f};
      xw = MFMA16(az0, bw[0], xw); xw = MFMA16(az1, bw[1], xw);
      xa = MFMA16(aa0, ba[0], xa); xa = MFMA16(aa1, ba[1], xa);
      const float w0c = CST[512 + c2], a0c = CST[576 + c2], kkc2 = CST[320 + c2], kac = CST[640 + c2], rkc = CST[704 + c2];
      float wv[4], kkv[4], bvv[4], kmv[4], rv4[4];
#pragma unroll
      for (int i = 0; i < 4; ++i) {
        const int t = tg * 4 + i;
        const float sgw = frcp(1.f + __expf(-(w0c + xw[i])));
        wv[i] = __expf(-0.6065306597126334f * sgw);
        const float a = frcp(1.f + __expf(-(a0c + xa[i])));
        const float k = KSs[t * 64 + c2];
        rv4[i] = RSs[t * 64 + c2];
        kkv[i] = k * kkc2 * INVN[t];
        bvv[i] = kkv[i] * a;
        kmv[i] = k * (1.f + (a - 1.f) * kac);
        const float bop = reduce16(rv4[i] * kmv[i] * rkc);
        if ((lane & 15) == 0) BONP[t * 4 + w] = bop;
      }
#pragma unroll
      for (int j = 0; j < 2; ++j) {
        const int ia = 2 * j, ib = 2 * j + 1, pp = 2 * tg + j;
        float* R = REC + pp * 768;
        R[c2] = kkv[ia]; R[64 + c2] = wv[ia] * kkv[ib]; R[128 + c2] = wv[ia] * rv4[ia]; R[192 + c2] = wv[ia] * wv[ib];
        R[256 + c2] = bvv[ia] * wv[ib]; R[320 + c2] = kmv[ia] * wv[ib]; R[384 + c2] = bvv[ib]; R[448 + c2] = kmv[ib]; R[512 + c2] = rv4[ib];
        const float s1 = reduce16(bvv[ia] * kkv[ib]), s2 = reduce16(kmv[ia] * kkv[ib]);
        const float s3 = reduce16(bvv[ia] * rv4[ia]), s4 = reduce16(kmv[ia] * rv4[ia]);
        if ((lane & 15) == 0) { SCP[(pp * 4 + 0) * 4 + w] = s1; SCP[(pp * 4 + 1) * 4 + w] = s2; SCP[(pp * 4 + 2) * 4 + w] = s3; SCP[(pp * 4 + 3) * 4 + w] = s4; }
      }
    }
    __syncthreads();
    if (ch >= RING && tid < 4 && cseen < (unsigned)(ch - RING + 1)) PC_WAIT(flag_ld(FLAG_CONS(chain, tid)) < (unsigned)(ch - RING + 1));
    if (tid < 32) {
      const f32x4 v = *(const f32x4*)(SCP + tid * 4);
      REC[(tid >> 2) * 768 + 704 + (tid & 3)] = (v[0] + v[1]) + (v[2] + v[3]);
    } else if (tid < 48) {
      const int tt = tid - 32;
      const f32x4 v = *(const f32x4*)(BONP + tt * 4);
      BONS[(size_t)(d * MROWS + b * TT + scan_tok(ch * 16 + tt, d)) * 8 + h] = (v[0] + v[1]) + (v[2] + v[3]);
    }
    __syncthreads();
    {
      gu64* dst = (gu64*)(ring + (size_t)(ch % RING) * SLOT_F);
      {
        const int pp = tid >> 5, k = tid & 31;
        const f32x2 wv2 = *(const f32x2*)(REC + pp * 768 + 192 + 2 * k);
        __hip_atomic_store(dst + tid, (unsigned long long)__float_as_uint(wv2[0]) | ((unsigned long long)__float_as_uint(wv2[1]) << 32), __ATOMIC_RELAXED, __HIP_MEMORY_SCOPE_AGENT);
      }
#pragma unroll
      for (int n = 0; n < 4; ++n) {
        const int idx = n * 256 + tid, pp = idx >> 7, vec = (idx >> 4) & 7, k = idx & 15;
        const f32x4 v = *(const f32x4*)(REC + pp * 768 + rec_voff(vec) + 4 * k);
        __hip_atomic_store(dst + 256 + idx, (unsigned long long)pk2(v[0], v[1]) | ((unsigned long long)pk2(v[2], v[3]) << 32), __ATOMIC_RELAXED, __HIP_MEMORY_SCOPE_AGENT);
      }
      {
        const int pp = tid >> 5, k = tid & 31;
        const f32x4 v = *(const f32x4*)(REC + pp * 768 + 576 + 4 * k);
        __hip_atomic_store(dst + 1280 + tid, (unsigned long long)pk2(v[0], v[1]) | ((unsigned long long)pk2(v[2], v[3]) << 32), __ATOMIC_RELAXED, __HIP_MEMORY_SCOPE_AGENT);
      }
      if (tid < 16) {
        const f32x2 sv2 = *(const f32x2*)(REC + (tid >> 1) * 768 + 704 + 2 * (tid & 1));
        __hip_atomic_store(dst + 1536 + tid, (unsigned long long)__float_as_uint(sv2[0]) | ((unsigned long long)__float_as_uint(sv2[1]) << 32), __ATOMIC_RELAXED, __HIP_MEMORY_SCOPE_AGENT);
      }
    }
    pub = ch;
  }
  asm volatile("s_waitcnt vmcnt(0)" ::: "memory");
  __syncthreads();
  if (tid == 0 && pub >= 0) flag_st(FLAG_PROD(chain, par), (unsigned)(pub + 1));
  __builtin_amdgcn_s_setprio(0);
#undef SCAN_LOAD
}

DI void red16x2(float& x, float& y) {
  asm("s_nop 1\n\tv_add_f32_dpp %0, %0, %0 quad_perm:[1,0,3,2] row_mask:0xf bank_mask:0xf\n\tv_add_f32_dpp %1, %1, %1 quad_perm:[1,0,3,2] row_mask:0xf bank_mask:0xf\n\ts_nop 0\n\t"
      "v_add_f32_dpp %0, %0, %0 quad_perm:[2,3,0,1] row_mask:0xf bank_mask:0xf\n\tv_add_f32_dpp %1, %1, %1 quad_perm:[2,3,0,1] row_mask:0xf bank_mask:0xf\n\ts_nop 0\n\t"
      "v_add_f32_dpp %0, %0, %0 row_ror:4 row_mask:0xf bank_mask:0xf\n\tv_add_f32_dpp %1, %1, %1 row_ror:4 row_mask:0xf bank_mask:0xf\n\ts_nop 0\n\t"
      "v_add_f32_dpp %0, %0, %0 row_ror:8 row_mask:0xf bank_mask:0xf\n\tv_add_f32_dpp %1, %1, %1 row_ror:8 row_mask:0xf bank_mask:0xf"
      : "+v"(x), "+v"(y));
}
DI void scan_consumer(const Params& p, char* smem, int chain, int split) {
  constexpr int RPB = 16, RPW = 4, LPR = 16, YPT = RPB * LPR;
  __builtin_amdgcn_s_setprio(3);
  const int tid = threadIdx.x, lane = tid & 63, w = tid >> 6;
  const int d = chain >> 5, b = (chain >> 3) & 3, h = chain & 7;
  float* REC = (float*)smem;
  float* YB = REC + 8 * 768;
  u16* YR = (u16*)(p.ws + OFF_OB);
  const float* ring = (const float*)(p.ws + OFF_RING) + (size_t)chain * RING * SLOT_F;
  const int t1 = tid >> 4, q = tid & 15;
  const int g = lane & (LPR - 1), rowb0 = w * RPW + (lane / LPR);
  f32x2 S0 = {0.f, 0.f}, S1 = {0.f, 0.f};
  unsigned long long nxA[7], nxB[7];
#define CONS_ISSUE(NX, CH)                                                                                              \
  {                                                                                                                     \
    const gu64* src_ = (const gu64*)(ring + (size_t)((CH) % RING) * SLOT_F);                                            \
    _Pragma("unroll") for (int j = 0; j < 6; ++j) NX[j] = __hip_atomic_load(src_ + j * 256 + tid, __ATOMIC_RELAXED, __HIP_MEMORY_SCOPE_AGENT); \
    NX[6] = 0ull;                                                                                                       \
    if (tid < 16) NX[6] = __hip_atomic_load(src_ + 1536 + tid, __ATOMIC_RELAXED, __HIP_MEMORY_SCOPE_AGENT);             \
  }
#define CONS_INSTALL(NX)                                                                                                \
  {                                                                                                                     \
    {                                                                                                                   \
      const int pp_ = tid >> 5, k_ = tid & 31;                                                                          \
      *(f32x2*)(REC + pp_ * 768 + 192 + 2 * k_) = (f32x2){__uint_as_float((unsigned)NX[0]), __uint_as_float((unsigned)(NX[0] >> 32))}; \
      const unsigned lo_ = (unsigned)NX[5], hi_ = (unsigned)(NX[5] >> 32);                                              \
      *(f32x4*)(REC + pp_ * 768 + 576 + 4 * k_) = (f32x4){bf_lo(lo_), bf_hi(lo_), bf_lo(hi_), bf_hi(hi_)};              \
    }                                                                                                                   \
    _Pragma("unroll") for (int n = 0; n < 4; ++n) {                                                                     \
      const int idx_ = n * 256 + tid, pp_ = idx_ >> 7, vec_ = (idx_ >> 4) & 7, k_ = idx_ & 15;                          \
      const unsigned lo_ = (unsigned)NX[1 + n], hi_ = (unsigned)(NX[1 + n] >> 32);                                      \
      *(f32x4*)(REC + pp_ * 768 + rec_voff(vec_) + 4 * k_) = (f32x4){bf_lo(lo_), bf_hi(lo_), bf_lo(hi_), bf_hi(hi_)};   \
    }                                                                                                                   \
    if (tid < 16) *(f32x2*)(REC + (tid >> 1) * 768 + 704 + 2 * (tid & 1)) = (f32x2){__uint_as_float((unsigned)NX[6]), __uint_as_float((unsigned)(NX[6] >> 32))}; \
  }
  if (tid == 0) PC_WAIT(flag_ld(FLAG_PROD(chain, 0)) < 1u);
  __syncthreads();
  CONS_ISSUE(nxA, 0)
  CONS_INSTALL(nxA)
  if (tid == 0) PC_WAIT(flag_ld(FLAG_PROD(chain, 1 % NPROD)) < 2u);
  __syncthreads();
  CONS_ISSUE(nxA, 1)
  unsigned fnext = 0u;
  if (tid == 0) fnext = flag_ld(FLAG_PROD(chain, 2 % NPROD));
#define CONS_FETCH(PP, BUF)                                                                                             \
  {                                                                                                                     \
    const float* Rb_ = REC + (PP) * 768;                                                                                \
    _Pragma("unroll") for (int f = 0; f < 9; ++f) L[BUF][f] = *(const f32x4*)(Rb_ + f * 64 + 4 * g);                    \
    vv[BUF] = *(const f32x2*)(Rb_ + 576 + (split * RPB + rowb0) * 2);                                                   \
    sc[BUF] = *(const f32x4*)(Rb_ + 704);                                                                               \
  }
#define CONS_ITER(CH, NXC, NXN)                                                                                         \
  {                                                                                                                     \
    const int ch = (CH);                                                                                                \
      \
    if (tid == 0 && ch + 3 < 272) fnext = flag_ld(FLAG_PROD(chain, (ch + 3) % NPROD));                                  \
    if (ch + 2 < 272) CONS_ISSUE(NXN, ch + 2)    \
    {                                                                                                                   \
      f32x4 L[2][9]; f32x2 vv[2]; f32x4 sc[2];                                                                          \
      CONS_FETCH(0, 0)                                                                                                  \
      _Pragma("unroll") for (int pp = 0; pp < 8; ++pp) {                                                                \
        const int cbf = pp & 1;                                                                                         \
        if (pp < 7) CONS_FETCH(pp + 1, cbf ^ 1)                                                                         \
        const f32x4 KA = L[cbf][0], P1 = L[cbf][1], P2 = L[cbf][2], W2 = L[cbf][3], B1 = L[cbf][4], K1 = L[cbf][5];     \
        const f32x4 BB = L[cbf][6], KBv = L[cbf][7], RB = L[cbf][8];                                                    \
        const float va = vv[cbf][0], vb = vv[cbf][1];                                                                   \
        f32x2 e1 = S0 * KA.xy; e1 += S1 * KA.zw;                                                                        \
        f32x2 e2 = S0 * P1.xy; e2 += S1 * P1.zw;                                                                        \
        f32x2 e3 = S0 * P2.xy; e3 += S1 * P2.zw;                                                                        \
        float sa_a = e1[0] + e1[1], raw2 = e2[0] + e2[1];                                                               \
        const float d3 = e3[0] + e3[1];                                                                                 \
        red16x2(sa_a, raw2);                                                                                            \
        const f32x2 va2 = {va, va}, vb2 = {vb, vb}, saa2 = {sa_a, sa_a};                                                \
        f32x2 pre0 = S0 * W2.xy + (va2 * K1.xy - saa2 * B1.xy) + vb2 * KBv.xy;                                          \
        f32x2 pre1 = S1 * W2.zw + (va2 * K1.zw - saa2 * B1.zw) + vb2 * KBv.zw;                                          \
        const float sa_b = raw2 - sa_a * sc[cbf][0] + va * sc[cbf][1];                                                  \
        const f32x2 sab2 = {sa_b, sa_b};                                                                                \
        S0 = pre0 - sab2 * BB.xy;                                                                                       \
        S1 = pre1 - sab2 * BB.zw;                                                                                       \
        const float fix = (g == 0) ? (va * sc[cbf][3] - sa_a * sc[cbf][2]) : 0.f;                                       \
        f32x2 yb2 = S0 * RB.xy; yb2 += S1 * RB.zw;                                                                      \
        YB[(2 * pp) * YPT + rowb0 * LPR + g] = d3 + fix;                                                                \
        YB[(2 * pp + 1) * YPT + rowb0 * LPR + g] = yb2[0] + yb2[1];                                                     \
      }                                                                                                                 \
    }                                                                                                                   \
    __syncthreads();                                                                                                    \
    {                                                                                                                   \
      const float* yp = YB + t1 * YPT + q * LPR;                                                                        \
      float a = 0.f;                                                                                                    \
      _Pragma("unroll") for (int k4 = 0; k4 < LPR / 4; ++k4) { const f32x4 v = *(const f32x4*)(yp + 4 * k4); a += (v[0] + v[1]) + (v[2] + v[3]); } \
      const unsigned orow = (unsigned)(d * MROWS + b * TT + scan_tok(ch * 16 + t1, d));                                 \
      YR[(size_t)orow * 512 + h * 64 + split * RPB + q] = bf1(a);                                                       \
    }                                                                                                                   \
    if (ch + 1 < 272) CONS_INSTALL(NXC)                                                                                 \
    if (tid == 0 && ch + 3 < 272 && fnext < (unsigned)(ch + 4)) PC_WAIT(flag_ld(FLAG_PROD(chain, (ch + 3) % NPROD)) < (unsigned)(ch + 4)); \
    __syncthreads();                                                                                                    \
    if (ch + 1 < 272 && tid == 0) flag_st(FLAG_CONS(chain, split), (unsigned)(ch + 2));     \
  }
  if (tid == 0 && fnext < 3u) PC_WAIT(flag_ld(FLAG_PROD(chain, 2 % NPROD)) < 3u);
  __syncthreads();
  for (int c2i = 0; c2i < 272; c2i += 2) {
    CONS_ITER(c2i, nxA, nxB)
    CONS_ITER(c2i + 1, nxB, nxA)
  }
#undef CONS_ISSUE
#undef CONS_INSTALL
#undef CONS_FETCH
#undef CONS_ITER
  __builtin_amdgcn_s_setprio(0);
}

DI void phase_mixer0(const Params& p, char* smem, int vb, int nvb) {
  constexpr int NROLE = 256 + 64 * NPROD;
  __shared__ int s_item;
  if (vb < 256) scan_consumer(p, smem, vb & 63, vb >> 6);
  else if (vb < NROLE) scan_producer(p, smem, (vb - 256) & 63, (vb - 256) >> 6);
  unsigned* ctr = (unsigned*)(p.ws + OFF_FLAGS) + 385 * 64;
  for (;;) {
    __syncthreads();
    if (threadIdx.x == 0) s_item = (int)__hip_atomic_fetch_add(ctr, 1u, __ATOMIC_RELAXED, __HIP_MEMORY_SCOPE_AGENT);
    __syncthreads();
    const int it = s_item;
    if (it >= 1088) break;
    if (it < 1024) {
      const int b = it >> 8, head = (it >> 5) & 7, qb = it & 31;
      attn_block(p, smem, 512, 2, b, head, qb * 128, 0, 68, 0, 0, false, false, 0.f);
    } else {
      const int j = it - 1024;
      const int b = j >> 4, head = (j >> 1) & 7, qb = j & 1;
      attn_block(p, smem, 512, 2, b, head, 4096 + qb * 128, 64, 4, 0, 0, false, false, 0.f);
    }
  }
}

DI void phase_combine(const Params& p, int vb, int nvb) {
  const u16* YR = (const u16*)(p.ws + OFF_OB);
  const u16* VSH = (const u16*)(p.ws + OFF_VSH);
  const float* BONS = (const float*)(p.ws + OFF_BONS);
  const u16* G = (const u16*)(p.ws + OFF_G);
  u16* A2 = (u16*)(p.ws + OFF_HX);
  const int q = threadIdx.x & 15, pi = threadIdx.x >> 4;
  for (int u = vb; u < MROWS * 8 / 16; u += nvb) {
    const int pair = u * 16 + pi;
    const size_t row = (size_t)(pair >> 3); const int h = pair & 7;
    const int col = h * 64 + 4 * q;
    const f32x4 gnw = *(const f32x4*)(p.gn_w_b + col), gnb = *(const f32x4*)(p.gn_b_b + col);
    const u32x2 vu = *(const u32x2*)(VSH + row * 512 + col);
    const float v0 = bf_lo(vu.x), v1 = bf_hi(vu.x), v2 = bf_lo(vu.y), v3 = bf_hi(vu.y);
    float a0 = 0.f, a1 = 0.f, a2 = 0.f, a3 = 0.f;
#pragma unroll
    for (int d = 0; d < 2; ++d) {
      const u32x2 yu = *(const u32x2*)(YR + ((size_t)d * MROWS + row) * 512 + col);
      const float y0 = bf_lo(yu.x), y1 = bf_hi(yu.x), y2 = bf_lo(yu.y), y3 = bf_hi(yu.y);
      const float mean = reduce16((y0 + y1) + (y2 + y3)) * (1.f / 64.f);
      const float d0 = y0 - mean, d1 = y1 - mean, d2 = y2 - mean, d3 = y3 - mean;
      const float var = reduce16(d0 * d0 + d1 * d1 + d2 * d2 + d3 * d3) * (1.f / 64.f);
      const float rstd = rsqrtf(var + 64e-5f);
      const float bon = BONS[((size_t)d * MROWS + row) * 8 + h];
      a0 += d0 * rstd * gnw[0] + gnb[0] + bon * v0; a1 += d1 * rstd * gnw[1] + gnb[1] + bon * v1;
      a2 += d2 * rstd * gnw[2] + gnb[2] + bon * v2; a3 += d3 * rstd * gnw[3] + gnb[3] + bon * v3;
    }
    const u32x2 gq = *(const u32x2*)(G + row * 1024 + 512 + col);
    *(u32x2*)(A2 + row * 1024 + 512 + col) = mk2(pk2(a0 * bf_lo(gq.x), a1 * bf_hi(gq.x)), pk2(a2 * bf_lo(gq.y), a3 * bf_hi(gq.y)));
  }
}

DI void phase_post(const Params& p, int vb, int nvb) {
  const int tid = threadIdx.x, lane = tid & 63, w = tid >> 6;
  const float* MOD = (const float*)(p.ws + OFF_MOD);
  const u16* Y = (const u16*)(p.ws + OFF_Y);
  u16* HX = (u16*)(p.ws + OFF_HX);
  for (int u = vb; u < MROWS / 4; u += nvb) {
    const int rowg = u * 4 + w;
    const int b = rowg / TT, tok = rowg - b * TT;
    const bool lat = tok < 4096;
    const float* src = lat ? p.x + ((size_t)b * 4096 + tok) * 1024 : p.ctx + ((size_t)b * 256 + (tok - 4096)) * 1024;
    const float* mod0 = MOD + (0 * 5 + (lat ? b : 4)) * 3072;
    const float* mod1 = MOD + (1 * 5 + (lat ? b : 4)) * 3072;
    f32x4 yv[4]; float ss = 0.f;
#pragma unroll
    for (int j = 0; j < 4; ++j) { const u32x2 yu = *(const u32x2*)(Y + (size_t)rowg * 1024 + j * 256 + lane * 4); yv[j] = (f32x4){bf_lo(yu.x), bf_hi(yu.x), bf_lo(yu.y), bf_hi(yu.y)}; ss += yv[j][0] * yv[j][0] + yv[j][1] * yv[j][1] + yv[j][2] * yv[j][2] + yv[j][3] * yv[j][3]; }
    ss = wave_sum(ss);
    const float rinv = rsqrtf(ss * (1.f / 1024.f) + 1e-6f);
    f32x4 x1[4]; float s1 = 0.f;
#pragma unroll
    for (int j = 0; j < 4; ++j) {
      const int col = j * 256 + lane * 4;
      const f32x4 xv = __builtin_nontemporal_load((const f32x4*)(src + col)), gp = *(const f32x4*)(p.g_post + col), gt = *(const f32x4*)(mod0 + 2048 + col);
#pragma unroll
      for (int e = 0; e < 4; ++e) { x1[j][e] = xv[e] + gt[e] * (yv[j][e] * rinv * gp[e]); s1 += x1[j][e] * x1[j][e]; }
      if (lat) __builtin_nontemporal_store(x1[j], (f32x4*)(p.out + ((size_t)b * 4096 + tok) * 1024 + col));
    }
    s1 = wave_sum(s1);
    const float rinv1 = rsqrtf(s1 * (1.f / 1024.f) + 1e-6f);
#pragma unroll
    for (int j = 0; j < 4; ++j) {
      const int col = j * 256 + lane * 4;
      const f32x4 g = *(const f32x4*)(p.g_pre + 1024 + col), sh = *(const f32x4*)(mod1 + col), scv = *(const f32x4*)(mod1 + 1024 + col);
      float hv[4];
#pragma unroll
      for (int e = 0; e < 4; ++e) hv[e] = (x1[j][e] * rinv1 * g[e]) * (1.f + scv[e]) + sh[e];
      *(u32x2*)(HX + (size_t)rowg * 1024 + col) = mk2(pk2(hv[0], hv[1]), pk2(hv[2], hv[3]));
    }
  }
}

DI void phase_attn1(const Params& p, char* smem, int vb, int nvb) {
  for (int it = vb; it < 2048; it += nvb) {
    const int b = it >> 9, head = (it >> 5) & 15, qb = it & 31;
    const int q0 = qb * 128;
    const int lo = (q0 - 128 < 0) ? 0 : q0 - 128, hi = (q0 + 256 > 4096) ? 4096 : q0 + 256;
    attn_block(p, smem, 1024, 4, b, head, q0, 64, 4, lo >> 6, (hi - lo) >> 6, true, true, p.sink_c[head] * 1.4426950408889634f);
  }
}

DI void phase_final(const Params& p, int vb, int nvb) {
  const int tid = threadIdx.x, lane = tid & 63, w = tid >> 6;
  const float* MOD = (const float*)(p.ws + OFF_MOD);
  const u16* Y = (const u16*)(p.ws + OFF_Y);
  for (int u = vb; u < 4096; u += nvb) {
    const int rowl = u * 4 + w;
    const int b = rowl >> 12, tok = rowl & 4095;
    const size_t rowg = (size_t)b * TT + tok;
    const float* mod1 = MOD + (1 * 5 + b) * 3072;
    f32x4 yv[4]; float ss = 0.f;
#pragma unroll
    for (int j = 0; j < 4; ++j) { const u32x2 yu = *(const u32x2*)(Y + rowg * 1024 + j * 256 + lane * 4); yv[j] = (f32x4){bf_lo(yu.x), bf_hi(yu.x), bf_lo(yu.y), bf_hi(yu.y)}; ss += yv[j][0] * yv[j][0] + yv[j][1] * yv[j][1] + yv[j][2] * yv[j][2] + yv[j][3] * yv[j][3]; }
    ss = wave_sum(ss);
    const float rinv = rsqrtf(ss * (1.f / 1024.f) + 1e-6f);
#pragma unroll
    for (int j = 0; j < 4; ++j) {
      const int col = j * 256 + lane * 4;
      float* op = p.out + (size_t)rowl * 1024 + col;
      const f32x4 xv = __builtin_nontemporal_load((const f32x4*)op), gp = *(const f32x4*)(p.g_post + 1024 + col), gt = *(const f32x4*)(mod1 + 2048 + col);
      f32x4 ov;
#pragma unroll
      for (int e = 0; e < 4; ++e) ov[e] = xv[e] + gt[e] * (yv[j][e] * rinv * gp[e]);
      __builtin_nontemporal_store(ov, (f32x4*)op);
    }
  }
}

#ifndef PHMASK
#define PHMASK 0x7ff
#endif
#ifndef LB2
#define LB2 2
#endif
#define PH_ON(i) (((PHMASK) >> (i)) & 1)
static constexpr int SMEM_BYTES = 73728;
__global__ void __launch_bounds__(256, LB2) hybrid_fwd(Params p) {
  extern __shared__ __attribute__((aligned(16))) char smem[];
  __shared__ u32x4 xb_words;
  cg::grid_group grid = cg::this_grid();
  const int vb = blockIdx.x, nvb = gridDim.x;
  XcdBarrier xb; xb.bar = (unsigned*)(p.ws + OFF_BAR); xb.x = 0; xb.st = (volatile LAS unsigned*)&xb_words;
  if (p.ph_hi - p.ph_lo > 1) {
    if (threadIdx.x == 0) xb_words = (u32x4){0u, 0u, 0u, 0u};
    __syncthreads();
    xb = xcd_barrier_post((unsigned*)(p.ws + OFF_BAR), (volatile LAS unsigned*)&xb_words);
  }
#ifndef DUP_PH
#define DUP_PH -1
#endif
#define RUN_PH(i, call)                                            \
  if (PH_ON(i) && p.ph_lo <= (i) && (i) < p.ph_hi) { call; if ((i) == DUP_PH) { __syncthreads(); call; } }         \
  if (p.ph_lo <= (i) && (i) + 1 < p.ph_hi) { if (p.ph_hi > 1000) grid.sync(); else xcd_barrier(xb); }
#ifdef EXTRA_SYNC
  for (int es = 0; es < EXTRA_SYNC; ++es) grid.sync();
#endif
  RUN_PH(0, phase_prep(p, smem, vb, nvb))
  int vid = vb;
  if (p.ph_hi - p.ph_lo > 1) {
    if (threadIdx.x == 0) {
      unsigned base = 0u;
#pragma unroll
      for (unsigned j = 0; j < 16; ++j) { const unsigned c = xb_ld(&xb.bar[XB_XCNT(j)]); base += (j < xb.x) ? c : 0u; }
      xb.st[3] = base + xb.st[2];
    }
    __syncthreads();
    vid = (int)xb.st[3];
  }
  RUN_PH(1, phase_prenorm0(p, vb, nvb))
  RUN_PH(2, gemm_phase<0>(p, smem, vb, nvb, (const u16*)(p.ws + OFF_WT0), (const u16*)(p.ws + OFF_HX), 28))
  RUN_PH(3, phase_mixer0(p, smem, vb, nvb))
  RUN_PH(4, phase_combine(p, vb, nvb))
  RUN_PH(5, gemm_phase<1>(p, smem, vb, nvb, (const u16*)(p.ws + OFF_WT1), (const u16*)(p.ws + OFF_HX), 8))
  RUN_PH(6, phase_post(p, vb, nvb))
  RUN_PH(7, gemm_phase<2>(p, smem, vb, nvb, (const u16*)(p.ws + OFF_WT2), (const u16*)(p.ws + OFF_HX), 20))
  RUN_PH(8, phase_attn1(p, smem, vb, nvb))
  RUN_PH(9, gemm_phase<3>(p, smem, vb, nvb, (const u16*)(p.ws + OFF_WT3), (const u16*)(p.ws + OFF_HX), 8))
  RUN_PH(10, phase_final(p, vb, nvb))
#undef RUN_PH
}

extern "C" void kernel_launch(void* const* d_in, const int* in_sizes, int n_in, void* d_out, int out_size, void* d_ws, size_t ws_size, hipStream_t stream) {
  static int grid_blocks = 0;
  if (grid_blocks == 0) {
    if (n_in != 27 || ws_size < WS_END) { fprintf(stderr, "kernel_launch: expected 27 inputs and >= %zu bytes of workspace (got %d, %zu)\n", (size_t)WS_END, n_in, ws_size); grid_blocks = -1; return; }
    int dev = 0, cus = 0, per_cu = 0;
    hipGetDevice(&dev);
    hipDeviceGetAttribute(&cus, hipDeviceAttributeMultiprocessorCount, dev);
    hipFuncSetAttribute((const void*)hybrid_fwd, hipFuncAttributeMaxDynamicSharedMemorySize, SMEM_BYTES);
    hipOccupancyMaxActiveBlocksPerMultiprocessor(&per_cu, hybrid_fwd, 256, SMEM_BYTES);
    if (per_cu < 1) per_cu = 1;
    if (per_cu > 2) per_cu = 2;
    grid_blocks = cus * per_cu;
    if (grid_blocks < 512) { fprintf(stderr, "kernel_launch: needs 512 co-resident blocks, got %d\n", grid_blocks); grid_blocks = -1; return; }
    grid_blocks = 512;
    fprintf(stderr, "kernel_launch: cus %d per_cu %d grid %d\n", cus, per_cu, grid_blocks);
  }
  if (grid_blocks < 0) return;
  Params p;
  memset(&p, 0, sizeof(p));
  const float** pp = (const float**)&p;
  for (int i = 0; i < 27; ++i) pp[i] = (const float*)d_in[i];
  p.out = (float*)d_out;
  p.ws = (unsigned char*)d_ws;
#if N_LAUNCH_MODE == 1
  p.ph_lo = 0; p.ph_hi = NPH;
  hipMemsetAsync((unsigned char*)d_ws + OFF_BAR, 0, 16384 + 131072, stream);
  void* args[] = {&p};
  hipError_t e = hipLaunchCooperativeKernel((void*)hybrid_fwd, dim3(grid_blocks), dim3(256), args, SMEM_BYTES, stream);
  if (e != hipSuccess) fprintf(stderr, "cooperative launch failed: %s (grid %d)\n", hipGetErrorString(e), grid_blocks);
#else
  for (int ph = 0; ph < NPH; ++ph) {
    p.ph_lo = ph; p.ph_hi = ph + 1;
    hipLaunchKernelGGL(hybrid_fwd, dim3(grid_blocks), dim3(256), SMEM_BYTES, stream, p);
  }
#endif
}
```

```cpp
#include <hip/hip_runtime.h>
#include <hip/hip_cooperative_groups.h>
#include <cstdio>
#include <cstdint>
#include <cstring>
namespace cg = cooperative_groups;

#ifndef N_LAUNCH_MODE
#define N_LAUNCH_MODE 1
#endif

typedef __attribute__((ext_vector_type(8))) short bf16x8;
typedef __attribute__((ext_vector_type(4))) short s16x4;
typedef __attribute__((ext_vector_type(4))) float f32x4;
typedef __attribute__((ext_vector_type(2))) float f32x2;
typedef __attribute__((ext_vector_type(16))) float f32x16;
typedef __attribute__((ext_vector_type(2))) __bf16 bf16x2_t;
typedef unsigned short u16;
typedef __attribute__((ext_vector_type(4))) unsigned u32x4;
typedef __attribute__((ext_vector_type(2))) unsigned u32x2;
#define DI __device__ __forceinline__
#define MFMA32(a, b, c) __builtin_amdgcn_mfma_f32_32x32x16_bf16((a), (b), (c), 0, 0, 0)
#define MFMA16(a, b, c) __builtin_amdgcn_mfma_f32_16x16x32_bf16((a), (b), (c), 0, 0, 0)

static constexpr int TT = 4352;
static constexpr int MROWS = 4 * TT;
static constexpr int NPH = 11;

static constexpr size_t OFF_WT0 = 0;
static constexpr size_t OFF_WT1 = OFF_WT0 + 7340032;
static constexpr size_t OFF_WT2 = OFF_WT1 + 2097152;
static constexpr size_t OFF_WT3 = OFF_WT2 + 5242880;
static constexpr size_t OFF_MOD = OFF_WT3 + 2097152;
static constexpr size_t OFF_HX  = OFF_MOD + 131072;
static constexpr size_t OFF_Q   = OFF_HX + 35651584;
static constexpr size_t OFF_KB  = OFF_Q + 35651584;
static constexpr size_t OFF_VT  = OFF_KB + 8912896;
static constexpr size_t OFF_PB  = OFF_VT + 8912896;
static constexpr size_t OFF_G   = OFF_PB + 62390272;
static constexpr size_t OFF_OB  = OFF_G + 35651584;
static constexpr size_t OFF_VSH = OFF_OB + 35651584;
static constexpr size_t OFF_BONS = OFF_VSH + 17825792;
static constexpr size_t OFF_BAR = OFF_BONS + 1114112;
static constexpr size_t OFF_FLAGS = OFF_BAR + 16384;
static constexpr size_t WS_END  = OFF_FLAGS + 131072;
static constexpr size_t OFF_Y   = OFF_PB;

struct Params {
  const float *x, *c, *ctx, *c_ctx, *w_mod, *b_mod, *g_pre, *g_post, *w_in_even, *w_out_even, *qn_a, *kn_a,
      *mu_b, *w0_b, *w2_b, *a0_b, *a2_b, *kk_b, *ka_b, *rk_b, *gn_w_b, *gn_b_b, *w_in_odd, *w_out_odd, *qn_c, *kn_c, *sink_c;
  float* out;
  unsigned char* ws;
  int ph_lo, ph_hi;
};

DI u32x4 mk4(unsigned a, unsigned b, unsigned c, unsigned d) { u32x4 v = {a, b, c, d}; return v; }
DI u32x2 mk2(unsigned a, unsigned b) { u32x2 v = {a, b}; return v; }
DI unsigned pk2(float lo, float hi) { f32x2 v = {lo, hi}; bf16x2_t b = __builtin_convertvector(v, bf16x2_t); return __builtin_bit_cast(unsigned, b); }
DI u16 bf1(float x) { return (u16)(pk2(x, 0.f) & 0xffffu); }
DI float bf_lo(unsigned u) { return __uint_as_float(u << 16); }
DI float bf_hi(unsigned u) { return __uint_as_float(u & 0xffff0000u); }
template <int CTRL> DI float dppf(float x) { return __int_as_float(__builtin_amdgcn_update_dpp(0, __float_as_int(x), CTRL, 0xF, 0xF, true)); }
DI float reduce16(float x) { x += dppf<0xB1>(x); x += dppf<0x4E>(x); x += dppf<0x124>(x); x += dppf<0x128>(x); return x; }
DI float reduce8(float x) { x += dppf<0xB1>(x); x += dppf<0x4E>(x); x += dppf<0x141>(x); return x; }
DI float wave_sum(float x) { for (int o = 32; o >= 1; o >>= 1) x += __shfl_xor(x, o); return x; }
DI float silu(float v) { return v / (1.f + __expf(-v)); }
DI float fexp2(float x) { return __builtin_amdgcn_exp2f(x); }


#define XB_TMO      128
#define XB_XCNT(j)  (256  + 64 * (j))
#define XB_XSUB(j)  (1280 + 64 * (j))
#define XB_XGEN(j)  (2304 + 64 * (j))
#define XB_TOP      3328
#define XB_TOPGEN   3392
#define XCD_BAR_WORDS 3456
#define XB_SPIN_CAP (1u << 20)
#define LAS __attribute__((address_space(3)))
DI unsigned xb_ld(unsigned* p) { return __hip_atomic_load(p, __ATOMIC_RELAXED, __HIP_MEMORY_SCOPE_AGENT); }
DI unsigned xb_add(unsigned* p, unsigned v) { return __hip_atomic_fetch_add(p, v, __ATOMIC_RELAXED, __HIP_MEMORY_SCOPE_AGENT); }
DI unsigned xb_xcc_id() { return (unsigned)__builtin_amdgcn_s_getreg((3 << 11) | 20) & 0xFu; }
#define XB_SPIN(cond, bar) do { unsigned _sp = 0; while (cond) { __builtin_amdgcn_s_sleep(1); \
    if ((++_sp & 255u) == 0u) { if (xb_ld(&(bar)[XB_TMO])) break; if (_sp > XB_SPIN_CAP) { atomicAdd(&(bar)[XB_TMO], 1u); break; } } } } while (0)
struct XcdBarrier { unsigned* bar; unsigned x; volatile LAS unsigned* st; };
DI XcdBarrier xcd_barrier_post(unsigned* bar, volatile LAS unsigned* st) {
  XcdBarrier b; b.bar = bar; b.x = xb_xcc_id(); b.st = st;
  if (threadIdx.x == 0) st[2] = xb_add(&bar[XB_XCNT(b.x)], 1u);
  return b;
}
DI void xcd_barrier_complete(unsigned* bar, unsigned x, unsigned& nloc, unsigned& nx) {
  const unsigned G = gridDim.x * gridDim.y * gridDim.z;
  unsigned sum, cnt, mine, sp = 0u;
  for (;;) {
    sum = 0u; cnt = 0u; mine = 0u;
#pragma unroll
    for (unsigned j = 0; j < 16; ++j) { const unsigned c = xb_ld(&bar[XB_XCNT(j)]); sum += c; cnt += (c > 0u) ? 1u : 0u; mine = (j == x) ? c : mine; }
    if (sum == G) break;
    __builtin_amdgcn_s_sleep(1);
    if ((++sp & 255u) == 0u) { if (xb_ld(&bar[XB_TMO])) break; if (sp > XB_SPIN_CAP) { atomicAdd(&bar[XB_TMO], 1u); break; } }
  }
  nloc = mine > 0u ? mine : 1u; nx = cnt > 0u ? cnt : 1u;
}
DI void xcd_barrier(const XcdBarrier& b) {
  asm volatile("s_waitcnt vmcnt(0)" ::: "memory");
  __syncthreads();
  if (threadIdx.x == 0) {
    unsigned* bar = b.bar;
    __builtin_amdgcn_s_waitcnt(0);
    unsigned nloc = b.st[0], nx = b.st[1];
    if (nloc == 0u) { xcd_barrier_complete(bar, b.x, nloc, nx); b.st[0] = nloc; b.st[1] = nx; }
    const unsigned old = xb_add(&bar[XB_XSUB(b.x)], 1u);
    const unsigned gen = old / nloc;
    if (old + 1u == (gen + 1u) * nloc) {
      __builtin_amdgcn_fence(__ATOMIC_RELEASE, "agent");
      asm volatile("s_waitcnt vmcnt(0)" ::: "memory");
      const unsigned og = xb_add(&bar[XB_TOP], 1u);
      const unsigned tg = og / nx;
      if (og + 1u == (tg + 1u) * nx) xb_add(&bar[XB_TOPGEN], 1u);
      else XB_SPIN(xb_ld(&bar[XB_TOPGEN]) == tg, bar);
      __builtin_amdgcn_fence(__ATOMIC_ACQUIRE, "agent");
      xb_add(&bar[XB_XGEN(b.x)], 1u);
      asm volatile("s_waitcnt vmcnt(0)" ::: "memory");
    } else {
      XB_SPIN(xb_ld(&bar[XB_XGEN(b.x)]) == gen, bar);
      __builtin_amdgcn_fence(__ATOMIC_ACQUIRE, "agent");
      asm volatile("s_waitcnt vmcnt(0)" ::: "memory");
    }
  }
  __syncthreads();
}

#define DPP_ADD(name, ctrl) DI float name(float x) { float r; asm("s_nop 1\n\tv_add_f32_dpp %0, %1, %1 " ctrl " row_mask:0xf bank_mask:0xf" : "=v"(r) : "v"(x)); return r; }
DPP_ADD(dpa_x1, "quad_perm:[1,0,3,2]")
DPP_ADD(dpa_x2, "quad_perm:[2,3,0,1]")
DPP_ADD(dpa_hm, "row_half_mirror")
DPP_ADD(dpa_r4, "row_ror:4")
DPP_ADD(dpa_r8, "row_ror:8")
template <int LPR> DI float red_lpr(float x) {
  x = dpa_x1(x); x = dpa_x2(x);
  if (LPR == 8) x = dpa_hm(x); else { x = dpa_r4(x); x = dpa_r8(x); }
  return x;
}

DI void phase_prep(const Params& p, char* smem, int vb, int nvb) {
  const int tid = threadIdx.x;
  float* tile = (float*)smem;
  float* sc = (float*)smem;
  float* part = sc + 5120;
  for (int u = vb; u < 2048 + 384; u += nvb) {
    if (u < 2048) {
      int ti = u; const float* W; u16* Wt; int N;
      if (ti < 896) { W = p.w_in_even; Wt = (u16*)(p.ws + OFF_WT0); N = 3584; }
      else if (ti < 1152) { ti -= 896; W = p.w_out_even; Wt = (u16*)(p.ws + OFF_WT1); N = 1024; }
      else if (ti < 1792) { ti -= 1152; W = p.w_in_odd; Wt = (u16*)(p.ws + OFF_WT2); N = 2560; }
      else { ti -= 1792; W = p.w_out_odd; Wt = (u16*)(p.ws + OFF_WT3); N = 1024; }
      const int ntn = N >> 6;
      const int kt = ti / ntn, nt = ti - kt * ntn;
#pragma unroll
      for (int ps = 0; ps < 4; ++ps) {
        const int row = (tid >> 4) + 16 * ps, c4 = (tid & 15) * 4;
        const f32x4 v = *(const f32x4*)(W + (size_t)(kt * 64 + row) * N + nt * 64 + c4);
        tile[row * 65 + c4 + 0] = v[0]; tile[row * 65 + c4 + 1] = v[1]; tile[row * 65 + c4 + 2] = v[2]; tile[row * 65 + c4 + 3] = v[3];
      }
      __syncthreads();
      const int n = tid >> 2, kq = (tid & 3) * 16;
      unsigned o[8];
#pragma unroll
      for (int j = 0; j < 8; ++j) o[j] = pk2(tile[(kq + 2 * j) * 65 + n], tile[(kq + 2 * j + 1) * 65 + n]);
      u32x4* dst = (u32x4*)(Wt + (size_t)(nt * 64 + n) * 1024 + kt * 64 + kq);
      dst[0] = mk4(o[0], o[1], o[2], o[3]);
      dst[1] = mk4(o[4], o[5], o[6], o[7]);
      __syncthreads();
    } else {
      const int u2 = u - 2048;
      const int l = u2 / 192, cb = u2 - l * 192;
      for (int idx = tid; idx < 5120; idx += 256) {
        const int s = idx >> 10, k = idx & 1023;
        const float v = (s < 4) ? p.c[s * 1024 + k] : p.c_ctx[k];
        sc[idx] = v / (1.f + expf(-v));
      }
      __syncthreads();
      const int col = tid & 15, kg = tid >> 4;
      float acc[5] = {0.f, 0.f, 0.f, 0.f, 0.f};
      const float* wp = p.w_mod + ((size_t)l * 1024 + kg * 64) * 3072 + cb * 16 + col;
#pragma unroll 16
      for (int k = 0; k < 64; ++k) {
        const float wv = wp[(size_t)k * 3072];
#pragma unroll
        for (int s = 0; s < 5; ++s) acc[s] += sc[s * 1024 + kg * 64 + k] * wv;
      }
#pragma unroll
      for (int s = 0; s < 5; ++s) part[(kg * 5 + s) * 16 + col] = acc[s];
      __syncthreads();
      if (tid < 80) {
        const int s = tid >> 4, cc = tid & 15;
        float a = 0.f;
        for (int g = 0; g < 16; ++g) a += part[(g * 5 + s) * 16 + cc];
        float* MOD = (float*)(p.ws + OFF_MOD);
        MOD[(l * 5 + s) * 3072 + cb * 16 + cc] = a + p.b_mod[l * 3072 + cb * 16 + cc];
      }
      __syncthreads();
    }
  }
}

DI void phase_prenorm0(const Params& p, int vb, int nvb) {
  const int tid = threadIdx.x, lane = tid & 63, w = tid >> 6;
  const float* MOD = (const float*)(p.ws + OFF_MOD);
  u16* HX = (u16*)(p.ws + OFF_HX);
  for (int u = vb; u < MROWS / 4; u += nvb) {
    const int rowg = u * 4 + w;
    const int b = rowg / TT, tok = rowg - b * TT;
    const bool lat = tok < 4096;
    const float* src = lat ? p.x + ((size_t)b * 4096 + tok) * 1024 : p.ctx + ((size_t)b * 256 + (tok - 4096)) * 1024;
    const float* mod = MOD + (0 * 5 + (lat ? b : 4)) * 3072;
    f32x4 v[4]; float ss = 0.f;
#pragma unroll
    for (int j = 0; j < 4; ++j) { v[j] = __builtin_nontemporal_load((const f32x4*)(src + j * 256 + lane * 4)); ss += v[j][0] * v[j][0] + v[j][1] * v[j][1] + v[j][2] * v[j][2] + v[j][3] * v[j][3]; }
    ss = wave_sum(ss);
    const float rinv = rsqrtf(ss * (1.f / 1024.f) + 1e-6f);
#pragma unroll
    for (int j = 0; j < 4; ++j) {
      const int col = j * 256 + lane * 4;
      const f32x4 g = *(const f32x4*)(p.g_pre + col), sh = *(const f32x4*)(mod + col), scv = *(const f32x4*)(mod + 1024 + col);
      float hv[4];
#pragma unroll
      for (int e = 0; e < 4; ++e) hv[e] = (v[j][e] * rinv * g[e]) * (1.f + scv[e]) + sh[e];
      *(u32x2*)(HX + (size_t)rowg * 1024 + col) = mk2(pk2(hv[0], hv[1]), pk2(hv[2], hv[3]));
    }
  }
}

template <int MODE>
DI void gemm_phase(const Params& p, char* smem, int vb, int nvb, const u16* __restrict__ Wt, const u16* __restrict__ X, int NT) {
  u16* As = (u16*)smem;
  u16* Bs = As + 2 * 128 * 72;
  const int tid = threadIdx.x, lane = tid & 63, w = tid >> 6, r = lane & 31, h = lane >> 5;
  const int wn = w & 1, wt = w >> 1;
  const int total = 136 * NT;
  const int NB4 = NT >> 2;
  for (int u = vb; u < total; u += nvb) {
    const int blk = u >> 5, wi = u & 31;
    const int mbk = blk / NB4, nbk = blk - mbk * NB4;
    const int mt = mbk * 8 + (wi >> 2), nt = nbk * 4 + (wi & 3);
    const bool ctx_tile = (mt % 34) >= 32;
    if (MODE == 2 && ctx_tile && (nt < 8 || nt >= 12)) continue;
    if (MODE == 3 && ctx_tile) continue;
    const u16* Wg = Wt + (size_t)(nt * 128) * 1024;
    const u16* Xg = X + (size_t)(mt * 128) * 1024;
    f32x16 acc[2][2];
#pragma unroll
    for (int a = 0; a < 2; ++a)
#pragma unroll
      for (int bq = 0; bq < 2; ++bq)
#pragma unroll
        for (int i = 0; i < 16; ++i) acc[a][bq][i] = 0.f;
    u32x4 ra[4], rb[4];
#define GEMM_LOAD(KT)                                                                                     \
    {                                                                                                     \
      _Pragma("unroll") for (int j = 0; j < 4; ++j) {                                                     \
        const int cidx = tid + 256 * j, row = cidx >> 3, part = cidx & 7;                                 \
        ra[j] = *(const u32x4*)(Wg + (size_t)row * 1024 + (KT) * 64 + part * 8);                          \
        rb[j] = *(const u32x4*)(Xg + (size_t)row * 1024 + (KT) * 64 + part * 8);                          \
      }                                                                                                   \
    }
#define GEMM_STORE(BUF)                                                                                   \
    {                                                                                                     \
      _Pragma("unroll") for (int j = 0; j < 4; ++j) {                                                     \
        const int cidx = tid + 256 * j, row = cidx >> 3, part = cidx & 7;                                 \
        *(u32x4*)(As + (BUF) * 9216 + row * 72 + part * 8) = ra[j];                                      \
        *(u32x4*)(Bs + (BUF) * 9216 + row * 72 + part * 8) = rb[j];                                      \
      }                                                                                                   \
    }
    GEMM_LOAD(0)
    GEMM_STORE(0)
    GEMM_LOAD(1)
    __syncthreads();
    for (int kt = 0; kt < 16; ++kt) {
      const int cbuf = kt & 1;
      const u16* Ac = As + cbuf * 9216;
      const u16* Bc = Bs + cbuf * 9216;
#pragma unroll
      for (int ks = 0; ks < 4; ++ks) {
        const bf16x8 a0 = *(const bf16x8*)(Ac + (wn * 64 + r) * 72 + ks * 16 + h * 8);
        const bf16x8 a1 = *(const bf16x8*)(Ac + (wn * 64 + 32 + r) * 72 + ks * 16 + h * 8);
        const bf16x8 b0 = *(const bf16x8*)(Bc + (wt * 64 + r) * 72 + ks * 16 + h * 8);
        const bf16x8 b1 = *(const bf16x8*)(Bc + (wt * 64 + 32 + r) * 72 + ks * 16 + h * 8);
        acc[0][0] = MFMA32(a0, b0, acc[0][0]);
        acc[0][1] = MFMA32(a0, b1, acc[0][1]);
        acc[1][0] = MFMA32(a1, b0, acc[1][0]);
        acc[1][1] = MFMA32(a1, b1, acc[1][1]);
      }
      __builtin_amdgcn_sched_barrier(0);
      if (kt + 1 < 16) GEMM_STORE(cbuf ^ 1)
      if (kt + 2 < 16) GEMM_LOAD(kt + 2)
      __syncthreads();
    }
#undef GEMM_LOAD
#undef GEMM_STORE
    const int nbase = nt * 128 + wn * 64;
    if (MODE == 1 || MODE == 3) {
      u16* Y = (u16*)(p.ws + OFF_Y);
#pragma unroll
      for (int tb = 0; tb < 2; ++tb) {
        const int rowg = mt * 128 + wt * 64 + tb * 32 + r;
#pragma unroll
        for (int nb = 0; nb < 2; ++nb)
#pragma unroll
          for (int ig = 0; ig < 4; ++ig) {
            *(u32x2*)(Y + (size_t)rowg * 1024 + nbase + nb * 32 + 8 * ig + 4 * h) =
                mk2(pk2(acc[nb][tb][4 * ig], acc[nb][tb][4 * ig + 1]), pk2(acc[nb][tb][4 * ig + 2], acc[nb][tb][4 * ig + 3]));
          }
      }
    } else {
      const int seg = nbase >> 6;
      int kind, hidx, QP, Gn, gateoff; const float* gain;
      if (MODE == 0) {
        QP = 512; Gn = 2;
        if (seg < 8) { kind = 0; hidx = seg; gain = p.qn_a; }
        else if (seg < 10) { kind = 1; hidx = seg - 8; gain = p.kn_a; }
        else if (seg < 12) { kind = 2; hidx = seg - 10; gain = nullptr; }
        else if (seg < 40) { kind = 3; hidx = 0; gain = nullptr; }
        else { kind = 4; hidx = 0; gain = nullptr; }
        gateoff = 2560;
      } else {
        QP = 1024; Gn = 4;
        if (seg < 16) { kind = 0; hidx = seg; gain = p.qn_c; }
        else if (seg < 20) { kind = 1; hidx = seg - 16; gain = p.kn_c; }
        else if (seg < 24) { kind = 2; hidx = seg - 20; gain = nullptr; }
        else { kind = 4; hidx = 0; gain = nullptr; }
        gateoff = 1536;
      }
      u16* Q = (u16*)(p.ws + OFF_Q);
      u16* KB = (u16*)(p.ws + OFF_KB);
      u16* VT = (u16*)(p.ws + OFF_VT);
      u16* PB = (u16*)(p.ws + OFF_PB);
      u16* G = (u16*)(p.ws + OFF_G);
#pragma unroll
      for (int tb = 0; tb < 2; ++tb) {
        const int rowg = mt * 128 + wt * 64 + tb * 32 + r;
        const int b = rowg / TT, tok = rowg - b * TT;
        const bool lat = tok < 4096;
        if (kind <= 1) {
          float ss = 0.f;
#pragma unroll
          for (int nb = 0; nb < 2; ++nb)
#pragma unroll
            for (int i = 0; i < 16; ++i) ss += acc[nb][tb][i] * acc[nb][tb][i];
          ss += __shfl_xor(ss, 32);
          const float rinv = rsqrtf(ss * (1.f / 64.f) + 1e-6f);
          const float prow = (float)(tok >> 6), pcol = (float)(tok & 63);
          const float osc = (kind == 0) ? 0.125f * 1.4426950408889634f : 1.f;
#pragma unroll
          for (int nb = 0; nb < 2; ++nb)
#pragma unroll
            for (int ig = 0; ig < 4; ++ig) {
              const int nin = nb * 32 + 8 * ig + 4 * h;
              const f32x4 gv = *(const f32x4*)(gain + nin);
              float xv[4];
#pragma unroll
              for (int e = 0; e < 4; ++e) xv[e] = acc[nb][tb][4 * ig + e] * rinv * gv[e];
              if (lat) {
#pragma unroll
                for (int pr = 0; pr < 2; ++pr) {
                  const int j = 4 * ig + 2 * h + pr;
                  const float ang = (nb == 0 ? prow : pcol) * exp2f(-(float)j * 0.8304820237218405f);
                  const float cs = __cosf(ang), sn = __sinf(ang);
                  const float x1 = xv[2 * pr], x2 = xv[2 * pr + 1];
                  xv[2 * pr] = x1 * cs - x2 * sn;
                  xv[2 * pr + 1] = x1 * sn + x2 * cs;
                }
              }
              const u32x2 o = mk2(pk2(xv[0] * osc, xv[1] * osc), pk2(xv[2] * osc, xv[3] * osc));
              if (kind == 0) *(u32x2*)(Q + (size_t)rowg * QP + hidx * 64 + nin) = o;
              else *(u32x2*)(KB + ((size_t)(b * Gn + hidx) * TT + tok) * 64 + nin) = o;
            }
        } else if (kind == 2) {
#pragma unroll
          for (int nb = 0; nb < 2; ++nb)
#pragma unroll
            for (int i = 0; i < 16; ++i) {
              const int dd = nb * 32 + (i & 3) + 8 * (i >> 2) + 4 * h;
              VT[((size_t)(b * Gn + hidx) * 64 + dd) * TT + tok] = bf1(acc[nb][tb][i]);
            }
        } else if (kind == 3) {
#pragma unroll
          for (int nb = 0; nb < 2; ++nb)
#pragma unroll
            for (int ig = 0; ig < 4; ++ig)
              *(u32x2*)(PB + (size_t)rowg * 1792 + (nbase - 768) + nb * 32 + 8 * ig + 4 * h) =
                  mk2(pk2(acc[nb][tb][4 * ig], acc[nb][tb][4 * ig + 1]), pk2(acc[nb][tb][4 * ig + 2], acc[nb][tb][4 * ig + 3]));
        } else {
#pragma unroll
          for (int nb = 0; nb < 2; ++nb)
#pragma unroll
            for (int ig = 0; ig < 4; ++ig)
              *(u32x2*)(G + (size_t)rowg * 1024 + (nbase - gateoff) + nb * 32 + 8 * ig + 4 * h) =
                  mk2(pk2(silu(acc[nb][tb][4 * ig]), silu(acc[nb][tb][4 * ig + 1])), pk2(silu(acc[nb][tb][4 * ig + 2]), silu(acc[nb][tb][4 * ig + 3])));
        }
      }
    }
  }
}

DI void attn_block(const Params& p, char* smem, int QP, int Gn, int b, int head, int qtok0,
                   int t_first, int n_first, int t_second, int n_second, bool win, bool has_sink, float sink2) {
  u16* Ks = (u16*)smem;
  u16* Vs = Ks + 64 * 72;
  const u16* Q = (const u16*)(p.ws + OFF_Q);
  const u16* G = (const u16*)(p.ws + OFF_G);
  u16* A2 = (u16*)(p.ws + OFF_HX);
  const int tid = threadIdx.x, lane = tid & 63, w = tid >> 6, r = lane & 31, h = lane >> 5;
  const int g = head >> 2;
  const u16* Kg = (const u16*)(p.ws + OFF_KB) + (size_t)(b * Gn + g) * TT * 64;
  const u16* Vg = (const u16*)(p.ws + OFF_VT) + (size_t)(b * Gn + g) * 64 * TT;
  const int qtok = qtok0 + w * 32 + r;
  const size_t qrow = (size_t)b * TT + qtok;
  bf16x8 qf[4];
#pragma unroll
  for (int ks = 0; ks < 4; ++ks) qf[ks] = *(const bf16x8*)(Q + qrow * QP + head * 64 + ks * 16 + h * 8);
  f32x16 o[2];
#pragma unroll
  for (int db = 0; db < 2; ++db)
#pragma unroll
    for (int i = 0; i < 16; ++i) o[db][i] = 0.f;
  float m = -INFINITY, l = 0.f;
  const int ntot = n_first + n_second;
  u32x4 rk[2], rv[2];
  {
    const int tile = (0 < n_first) ? t_first : t_second;
#pragma unroll
    for (int j = 0; j < 2; ++j) {
      const int cidx = tid + 256 * j, row = cidx >> 3, part = cidx & 7;
      rk[j] = *(const u32x4*)(Kg + (size_t)(tile * 64 + row) * 64 + part * 8);
      rv[j] = *(const u32x4*)(Vg + (size_t)row * TT + tile * 64 + part * 8);
    }
  }
  for (int it = 0; it < ntot; ++it) {
    const int tile = (it < n_first) ? (t_first + it) : (t_second + it - n_first);
    __syncthreads();
#pragma unroll
    for (int j = 0; j < 2; ++j) {
      const int cidx = tid + 256 * j, row = cidx >> 3, part = cidx & 7;
      *(u32x4*)(Ks + row * 72 + part * 8) = rk[j];
      *(u32x4*)(Vs + row * 72 + part * 8) = rv[j];
    }
    __syncthreads();
    if (it + 1 < ntot) {
      const int tn = (it + 1 < n_first) ? (t_first + it + 1) : (t_second + it + 1 - n_first);
#pragma unroll
      for (int j = 0; j < 2; ++j) {
        const int cidx = tid + 256 * j, row = cidx >> 3, part = cidx & 7;
        rk[j] = *(const u32x4*)(Kg + (size_t)(tn * 64 + row) * 64 + part * 8);
        rv[j] = *(const u32x4*)(Vg + (size_t)row * TT + tn * 64 + part * 8);
      }
    }
    __builtin_amdgcn_sched_barrier(0);
    const int qw0 = qtok0 + w * 32;
    const bool live = !win || tile >= 64 || (tile * 64 <= qw0 + 31 + 128 && tile * 64 + 63 >= qw0 - 128);
    if (live) {
    f32x16 s[2];
#pragma unroll
    for (int kb = 0; kb < 2; ++kb) {
#pragma unroll
      for (int i = 0; i < 16; ++i) s[kb][i] = 0.f;
#pragma unroll
      for (int ks = 0; ks < 4; ++ks) {
        const bf16x8 a = *(const bf16x8*)(Ks + (kb * 32 + r) * 72 + ks * 16 + h * 8);
        s[kb] = MFMA32(a, qf[ks], s[kb]);
      }
    }
    if (win && tile < 64) {
#pragma unroll
      for (int kb = 0; kb < 2; ++kb)
#pragma unroll
        for (int i = 0; i < 16; ++i) {
          const int key = tile * 64 + kb * 32 + (i & 3) + 8 * (i >> 2) + 4 * h;
          const int dl = key - qtok;
          if (dl > 128 || dl < -128) s[kb][i] = -INFINITY;
        }
    }
    float mx = -INFINITY;
#pragma unroll
    for (int kb = 0; kb < 2; ++kb)
#pragma unroll
      for (int i = 0; i < 16; ++i) mx = fmaxf(mx, s[kb][i]);
    mx = fmaxf(mx, __shfl_xor(mx, 32));
    float alpha = 1.f;
    if (!__all(mx - m <= 8.f)) {
      const float mn = fmaxf(m, mx);
      alpha = fexp2(m - mn);
      m = mn;
#pragma unroll
      for (int db = 0; db < 2; ++db)
#pragma unroll
        for (int i = 0; i < 16; ++i) o[db][i] *= alpha;
    }
    float ps = 0.f;
#pragma unroll
    for (int kb = 0; kb < 2; ++kb)
#pragma unroll
      for (int i = 0; i < 16; ++i) { s[kb][i] = fexp2(s[kb][i] - m); ps += s[kb][i]; }
    l = l * alpha + ps;
#pragma unroll
    for (int kb = 0; kb < 2; ++kb)
#pragma unroll
      for (int st = 0; st < 2; ++st) {
        const unsigned p0 = pk2(s[kb][8 * st + 0], s[kb][8 * st + 1]), p1 = pk2(s[kb][8 * st + 2], s[kb][8 * st + 3]);
        const unsigned p2 = pk2(s[kb][8 * st + 4], s[kb][8 * st + 5]), p3 = pk2(s[kb][8 * st + 6], s[kb][8 * st + 7]);
        const u32x4 pu = mk4(p0, p1, p2, p3);
        const bf16x8 pf = __builtin_bit_cast(bf16x8, pu);
#pragma unroll
        for (int db = 0; db < 2; ++db) {
          const s16x4 lo = *(const s16x4*)(Vs + (db * 32 + r) * 72 + kb * 32 + 16 * st + 4 * h);
          const s16x4 hi = *(const s16x4*)(Vs + (db * 32 + r) * 72 + kb * 32 + 16 * st + 8 + 4 * h);
          const bf16x8 vf = __builtin_shufflevector(lo, hi, 0, 1, 2, 3, 4, 5, 6, 7);
          o[db] = MFMA32(vf, pf, o[db]);
        }
      }
    }
  }
  l += __shfl_xor(l, 32);
  if (has_sink) {
    const float mn = fmaxf(m, sink2);
    const float alpha = fexp2(m - mn);
    l = l * alpha + fexp2(sink2 - mn);
#pragma unroll
    for (int db = 0; db < 2; ++db)
#pragma unroll
      for (int i = 0; i < 16; ++i) o[db][i] *= alpha;
  }
  const float inv = 1.f / l;
#pragma unroll
  for (int db = 0; db < 2; ++db)
#pragma unroll
    for (int ig = 0; ig < 4; ++ig) {
      const int dd = db * 32 + 8 * ig + 4 * h;
      const u32x2 gt = *(const u32x2*)(G + qrow * 1024 + head * 64 + dd);
      const float v0 = o[db][4 * ig] * inv * bf_lo(gt.x), v1 = o[db][4 * ig + 1] * inv * bf_hi(gt.x);
      const float v2 = o[db][4 * ig + 2] * inv * bf_lo(gt.y), v3 = o[db][4 * ig + 3] * inv * bf_hi(gt.y);
      *(u32x2*)(A2 + qrow * 1024 + head * 64 + dd) = mk2(pk2(v0, v1), pk2(v2, v3));
    }
}

DI int scan_tok(int s, int d) {
  if (s < 256) return 4096 + (d ? 255 - s : s);
  const int i = s - 256;
  return d ? 4095 - i : i;
}

template <class T> DI T ldgo(const void* base, unsigned byteoff) { return *(const T*)((const char*)base + byteoff); }
DI int scan_segoff(int sg, int d, int h) { return sg < 3 ? sg * 512 + h * 64 : 1536 + (sg - 3) * 128 + d * 64; }
DI float frcp(float x) { return __builtin_amdgcn_rcpf(x); }
DI float tanh_fast(float x) { const float e = __expf(2.f * x); return 1.f - 2.f * frcp(e + 1.f); }

#define GAS __attribute__((address_space(1)))
typedef GAS unsigned long long gu64;
typedef GAS unsigned gu32;
static constexpr int RING = 21;
static constexpr int SLOT_F = 3200;
DI int rec_voff(int vec) { return vec * 64 + (vec >= 3 ? 64 : 0); }
static constexpr size_t OFF_RING = OFF_Q + 17825792;
DI unsigned flag_ld(unsigned* f) { return __hip_atomic_load(f, __ATOMIC_RELAXED, __HIP_MEMORY_SCOPE_AGENT); }
DI void flag_st(unsigned* f, unsigned v) { __hip_atomic_store(f, v, __ATOMIC_RELAXED, __HIP_MEMORY_SCOPE_AGENT); }
#define FLAG_PROD(chain, par) ((unsigned*)(p.ws + OFF_FLAGS) + ((chain) * 2 + (par)) * 64)
#define FLAG_CONS(chain, sp) ((unsigned*)(p.ws + OFF_FLAGS) + (128 + (chain) * 4 + (sp)) * 64)
#define FLAG_TMO ((unsigned*)(p.ws + OFF_FLAGS) + 384 * 64)
#define PC_WAIT(cond) do { unsigned _sp = 0; while (cond) { __builtin_amdgcn_s_sleep(1); \
    if ((++_sp & 1023u) == 0u) { if (flag_ld(FLAG_TMO)) break; if (_sp > (1u << 22)) { flag_st(FLAG_TMO, 1u); break; } } } } while (0)

#ifndef NPROD
#define NPROD 2
#endif
DI void scan_producer(const Params& p, char* smem, int chain, int par) {
  __builtin_amdgcn_s_setprio(2);
  const int tid = threadIdx.x, lane = tid & 63, w = tid >> 6;
  const int d = chain >> 5, b = (chain >> 3) & 3, h = chain & 7;
  float* REC = (float*)smem;
  float* RSs = REC + 8 * 768;
  float* KSs = RSs + 1024;
  float* INVN = KSs + 1024;
  float* SCP = INVN + 16;
  float* BONP = SCP + 128;
  float* CST = BONP + 64;
  u16* ZW = (u16*)(CST + 768);
  u16* ZA = ZW + 16 * 72;
  u16* RAW = ZA + 16 * 72;
  const u16* PB = (const u16*)(p.ws + OFF_PB);
  u16* VSH = (u16*)(p.ws + OFF_VSH);
  float* BONS = (float*)(p.ws + OFF_BONS);
  float* ring = (float*)(p.ws + OFF_RING) + (size_t)chain * RING * SLOT_F;

  if (tid < 64) {
    const unsigned hc = (unsigned)(h * 64 + tid) * 4u, dhc = (unsigned)(d * 512 + h * 64 + tid) * 4u;
#pragma unroll
    for (int sg = 0; sg < 5; ++sg) CST[sg * 64 + tid] = ldgo<float>(p.mu_b, (unsigned)(scan_segoff(sg, d, h) + tid) * 4u);
    CST[320 + tid] = ldgo<float>(p.kk_b, hc);
    CST[512 + tid] = ldgo<float>(p.w0_b, dhc);
    CST[576 + tid] = ldgo<float>(p.a0_b, dhc);
    CST[640 + tid] = ldgo<float>(p.ka_b, hc);
    CST[704 + tid] = ldgo<float>(p.rk_b, hc);
  }
  const int t1 = tid >> 4, q = tid & 15, c4 = q * 4;
  const int hhi = tid / 80, hsg = (tid % 80) >> 4;
  const int c2 = 16 * w + (lane & 15), tg = lane >> 4;
  bf16x8 bw[2], ba[2];
#pragma unroll
  for (int ks = 0; ks < 2; ++ks) {
    unsigned uw[4], ua[4];
#pragma unroll
    for (int e2 = 0; e2 < 4; ++e2) {
      const int j0 = tg * 8 + 32 * ks + 2 * e2;
      const unsigned o0 = (unsigned)((d * 64 + j0) * 512 + h * 64 + c2) * 4u;
      uw[e2] = pk2(ldgo<float>(p.w2_b, o0), ldgo<float>(p.w2_b, o0 + 2048u));
      ua[e2] = pk2(ldgo<float>(p.a2_b, o0), ldgo<float>(p.a2_b, o0 + 2048u));
    }
    bw[ks] = __builtin_bit_cast(bf16x8, mk4(uw[0], uw[1], uw[2], uw[3]));
    ba[ks] = __builtin_bit_cast(bf16x8, mk4(ua[0], ua[1], ua[2], ua[3]));
  }
  u32x2 pr[5], ph = mk2(0u, 0u);
  const unsigned pbase = (unsigned)(b * TT) * 3584u;
#define SCAN_LOAD(CH)                                                                                                   \
  {                                                                                                                     \
    const unsigned ro_ = pbase + (unsigned)scan_tok((CH) * 16 + t1, d) * 3584u + (unsigned)c4 * 2u;                     \
    _Pragma("unroll") for (int sg = 0; sg < 5; ++sg) pr[sg] = ldgo<u32x2>(PB, ro_ + (unsigned)scan_segoff(sg, d, h) * 2u); \
    if (tid < 160) {                                                                                                    \
      const int sh_ = hhi ? (CH) * 16 + 16 : (CH) * 16 - 1;                                                             \
      const bool valid_ = hhi ? (sh_ != 256 && sh_ != 4352) : (sh_ != -1 && sh_ != 255);                               \
      ph = mk2(0u, 0u);                                                                                                 \
      if (valid_) ph = ldgo<u32x2>(PB, pbase + (unsigned)scan_tok(sh_, d) * 3584u + (unsigned)(scan_segoff(hsg, d, h) + c4) * 2u); \
    }                                                                                                                   \
  }
  SCAN_LOAD(par)
  int pub = -1;
  for (int ch = par; ch < 272; ch += NPROD) {
#pragma unroll
    for (int sg = 0; sg < 5; ++sg) *(u32x2*)(RAW + (t1 + 1) * 320 + sg * 64 + c4) = pr[sg];
    if (tid < 160) *(u32x2*)(RAW + (hhi * 17) * 320 + hsg * 64 + c4) = ph;
    asm volatile("s_waitcnt vmcnt(0)" ::: "memory");
    __syncthreads();
    if (tid == 0 && pub >= 0) flag_st(FLAG_PROD(chain, par), (unsigned)(pub + 1));
    unsigned cseen = 0xffffffffu;
    if (ch >= RING && tid < 4) cseen = flag_ld(FLAG_CONS(chain, tid));
    const int tok = scan_tok(ch * 16 + t1, d);
    {
      float sv[5][4];
#pragma unroll
      for (int sg = 0; sg < 5; ++sg) {
        const u32x2 cu = *(const u32x2*)(RAW + (t1 + 1) * 320 + sg * 64 + c4);
        const u32x2 pu = *(const u32x2*)(RAW + t1 * 320 + sg * 64 + c4);
        const u32x2 nu = *(const u32x2*)(RAW + (t1 + 2) * 320 + sg * 64 + c4);
        const f32x4 mu = *(const f32x4*)(CST + sg * 64 + c4);
        const float c0 = bf_lo(cu.x), c1 = bf_hi(cu.x), c2v = bf_lo(cu.y), c3 = bf_hi(cu.y);
        const float n0 = 0.5f * (bf_lo(pu.x) + bf_lo(nu.x)), n1 = 0.5f * (bf_hi(pu.x) + bf_hi(nu.x));
        const float n2 = 0.5f * (bf_lo(pu.y) + bf_lo(nu.y)), n3 = 0.5f * (bf_hi(pu.y) + bf_hi(nu.y));
        sv[sg][0] = c0 + mu[0] * (n0 - c0); sv[sg][1] = c1 + mu[1] * (n1 - c1);
        sv[sg][2] = c2v + mu[2] * (n2 - c2v); sv[sg][3] = c3 + mu[3] * (n3 - c3);
      }
      *(f32x4*)(RSs + t1 * 64 + c4) = (f32x4){sv[0][0], sv[0][1], sv[0][2], sv[0][3]};
      *(f32x4*)(KSs + t1 * 64 + c4) = (f32x4){sv[1][0], sv[1][1], sv[1][2], sv[1][3]};
      {
        float* vp = REC + (t1 >> 1) * 768 + 576 + c4 * 2 + (t1 & 1);
        vp[0] = sv[2][0]; vp[2] = sv[2][1]; vp[4] = sv[2][2]; vp[6] = sv[2][3];
      }
      if (d == 0) *(u32x2*)(VSH + (size_t)(b * TT + tok) * 512 + h * 64 + c4) = mk2(pk2(sv[2][0], sv[2][1]), pk2(sv[2][2], sv[2][3]));
      *(u32x2*)(ZW + t1 * 72 + c4) = mk2(pk2(tanh_fast(sv[3][0]), tanh_fast(sv[3][1])), pk2(tanh_fast(sv[3][2]), tanh_fast(sv[3][3])));
      *(u32x2*)(ZA + t1 * 72 + c4) = mk2(pk2(sv[4][0], sv[4][1]), pk2(sv[4][2], sv[4][3]));
      const f32x4 kkc1 = *(const f32x4*)(CST + 320 + c4);
      float ssq = 0.f;
#pragma unroll
      for (int e = 0; e < 4; ++e) { const float kq = sv[1][e] * kkc1[e]; ssq += kq * kq; }
      ssq = reduce16(ssq);
      if (q == 0) INVN[t1] = frcp(fmaxf(sqrtf(ssq), 1e-12f));
    }
    if (ch + NPROD < 272) SCAN_LOAD(ch + NPROD)
    __syncthreads();
    {
      const bf16x8 az0 = *(const bf16x8*)(ZW + (lane & 15) * 72 + tg * 8), az1 = *(const bf16x8*)(ZW + (lane & 15) * 72 + tg * 8 + 32);
      const bf16x8 aa0 = *(const bf16x8*)(ZA + (lane & 15) * 72 + tg * 8), aa1 = *(const bf16x8*)(ZA + (lane & 15) * 72 + tg * 8 + 32);
      f32x4 xw = {0.f, 0.f, 0.f, 0.f}, xa = {0.f, 0.f, 0.f, 0.f};
      xw = MFMA16(az0, bw[0], xw); xw = MFMA16(az1, bw[1], xw);
      xa = MFMA16(aa0, ba[0], xa); xa = MFMA16(aa1, ba[1], xa);
      const float w0c = CST[512 + c2], a0c = CST[576 + c2], kkc2 = CST[320 + c2], kac = CST[640 + c2], rkc = CST[704 + c2];
      float wv[4], kkv[4], bvv[4], kmv[4], rv4[4];
#pragma unroll
      for (int i = 0; i < 4; ++i) {
        const int t = tg * 4 + i;
        const float sgw = frcp(1.f + __expf(-(w0c + xw[i])));
        wv[i] = __expf(-0.6065306597126334f * sgw);
        const float a = frcp(1.f + __expf(-(a0c + xa[i])));
        const float k = KSs[t * 64 + c2];
        rv4[i] = RSs[t * 64 + c2];
        kkv[i] = k * kkc2 * INVN[t];
        bvv[i] = kkv[i] * a;
        kmv[i] = k * (1.f + (a - 1.f) * kac);
        const float bop = reduce16(rv4[i] * kmv[i] * rkc);
        if ((lane & 15) == 0) BONP[t * 4 + w] = bop;
      }
#pragma unroll
      for (int j = 0; j < 2; ++j) {
        const int ia = 2 * j, ib = 2 * j + 1, pp = 2 * tg + j;
        float* R = REC + pp * 768;
        R[c2] = kkv[ia]; R[64 + c2] = wv[ia] * kkv[ib]; R[128 + c2] = wv[ia] * rv4[ia]; R[192 + c2] = wv[ia] * wv[ib];
        R[256 + c2] = bvv[ia] * wv[ib]; R[320 + c2] = kmv[ia] * wv[ib]; R[384 + c2] = bvv[ib]; R[448 + c2] = kmv[ib]; R[512 + c2] = rv4[ib];
        const float s1 = reduce16(bvv[ia] * kkv[ib]), s2 = reduce16(kmv[ia] * kkv[ib]);
        const float s3 = reduce16(bvv[ia] * rv4[ia]), s4 = reduce16(kmv[ia] * rv4[ia]);
        if ((lane & 15) == 0) { SCP[(pp * 4 + 0) * 4 + w] = s1; SCP[(pp * 4 + 1) * 4 + w] = s2; SCP[(pp * 4 + 2) * 4 + w] = s3; SCP[(pp * 4 + 3) * 4 + w] = s4; }
      }
    }
    __syncthreads();
    if (ch >= RING && tid < 4 && cseen < (unsigned)(ch - RING + 1)) PC_WAIT(flag_ld(FLAG_CONS(chain, tid)) < (unsigned)(ch - RING + 1));
    if (tid < 32) {
      const f32x4 v = *(const f32x4*)(SCP + tid * 4);
      REC[(tid >> 2) * 768 + 704 + (tid & 3)] = (v[0] + v[1]) + (v[2] + v[3]);
    } else if (tid < 48) {
      const int tt = tid - 32;
      const f32x4 v = *(const f32x4*)(BONP + tt * 4);
      BONS[(size_t)(d * MROWS + b * TT + scan_tok(ch * 16 + tt, d)) * 8 + h] = (v[0] + v[1]) + (v[2] + v[3]);
    }
    __syncthreads();
    {
      gu64* dst = (gu64*)(ring + (size_t)(ch % RING) * SLOT_F);
      {
        const int pp = tid >> 5, k = tid & 31;
        const f32x2 wv2 = *(const f32x2*)(REC + pp * 768 + 192 + 2 * k);
        __hip_atomic_store(dst + tid, (unsigned long long)__float_as_uint(wv2[0]) | ((unsigned long long)__float_as_uint(wv2[1]) << 32), __ATOMIC_RELAXED, __HIP_MEMORY_SCOPE_AGENT);
      }
#pragma unroll
      for (int n = 0; n < 4; ++n) {
        const int idx = n * 256 + tid, pp = idx >> 7, vec = (idx >> 4) & 7, k = idx & 15;
        const f32x4 v = *(const f32x4*)(REC + pp * 768 + rec_voff(vec) + 4 * k);
        __hip_atomic_store(dst + 256 + idx, (unsigned long long)pk2(v[0], v[1]) | ((unsigned long long)pk2(v[2], v[3]) << 32), __ATOMIC_RELAXED, __HIP_MEMORY_SCOPE_AGENT);
      }
      {
        const int pp = tid >> 5, k = tid & 31;
        const f32x4 v = *(const f32x4*)(REC + pp * 768 + 576 + 4 * k);
        __hip_atomic_store(dst + 1280 + tid, (unsigned long long)pk2(v[0], v[1]) | ((unsigned long long)pk2(v[2], v[3]) << 32), __ATOMIC_RELAXED, __HIP_MEMORY_SCOPE_AGENT);
      }
      if (tid < 16) {
        const f32x2 sv2 = *(const f32x2*)(REC + (tid >> 1) * 768 + 704 + 2 * (tid & 1));
        __hip_atomic_store(dst + 1536 + tid, (unsigned long long)__float_as_uint(sv2[0]) | ((unsigned long long)__float_as_uint(sv2[1]) << 32), __ATOMIC_RELAXED, __HIP_MEMORY_SCOPE_AGENT);
      }
    }
    pub = ch;
  }
  asm volatile("s_waitcnt vmcnt(0)" ::: "memory");
  __syncthreads();
  if (tid == 0 && pub >= 0) flag_st(FLAG_PROD(chain, par), (unsigned)(pub + 1));
  __builtin_amdgcn_s_setprio(0);
#undef SCAN_LOAD
}

DI void red16x2(float& x, float& y) {
  asm("s_nop 1\n\tv_add_f32_dpp %0, %0, %0 quad_perm:[1,0,3,2] row_mask:0xf bank_mask:0xf\n\tv_add_f32_dpp %1, %1, %1 quad_perm:[1,0,3,2] row_mask:0xf bank_mask:0xf\n\ts_nop 0\n\t"
      "v_add_f32_dpp %0, %0, %0 quad_perm:[2,3,0,1] row_mask:0xf bank_mask:0xf\n\tv_add_f32_dpp %1, %1, %1 quad_perm:[2,3,0,1] row_mask:0xf bank_mask:0xf\n\ts_nop 0\n\t"
      "v_add_f32_dpp %0, %0, %0 row_ror:4 row_mask:0xf bank_mask:0xf\n\tv_add_f32_dpp %1, %1, %1 row_ror:4 row_mask:0xf bank_mask:0xf\n\ts_nop 0\n\t"
      "v_add_f32_dpp %0, %0, %0 row_ror:8 row_mask:0xf bank_mask:0xf\n\tv_add_f32_dpp %1, %1, %1 row_ror:8 row_mask:0xf bank_mask:0xf"
      : "+v"(x), "+v"(y));
}
DI void scan_consumer(const Params& p, char* smem, int chain, int split) {
  constexpr int RPB = 16, RPW = 4, LPR = 16, YPT = RPB * LPR;
  __builtin_amdgcn_s_setprio(3);
  const int tid = threadIdx.x, lane = tid & 63, w = tid >> 6;
  const int d = chain >> 5, b = (chain >> 3) & 3, h = chain & 7;
  float* REC = (float*)smem;
  float* YB = REC + 8 * 768;
  u16* YR = (u16*)(p.ws + OFF_OB);
  const float* ring = (const float*)(p.ws + OFF_RING) + (size_t)chain * RING * SLOT_F;
  const int t1 = tid >> 4, q = tid & 15;
  const int g = lane & (LPR - 1), rowb0 = w * RPW + (lane / LPR);
  f32x2 S0 = {0.f, 0.f}, S1 = {0.f, 0.f};
  unsigned long long nxA[7], nxB[7];
#define CONS_ISSUE(NX, CH)                                                                                              \
  {                                                                                                                     \
    const gu64* src_ = (const gu64*)(ring + (size_t)((CH) % RING) * SLOT_F);                                            \
    _Pragma("unroll") for (int j = 0; j < 6; ++j) NX[j] = __hip_atomic_load(src_ + j * 256 + tid, __ATOMIC_RELAXED, __HIP_MEMORY_SCOPE_AGENT); \
    NX[6] = 0ull;                                                                                                       \
    if (tid < 16) NX[6] = __hip_atomic_load(src_ + 1536 + tid, __ATOMIC_RELAXED, __HIP_MEMORY_SCOPE_AGENT);             \
  }
#define CONS_INSTALL(NX)                                                                                                \
  {                                                                                                                     \
    {                                                                                                                   \
      const int pp_ = tid >> 5, k_ = tid & 31;                                                                          \
      *(f32x2*)(REC + pp_ * 768 + 192 + 2 * k_) = (f32x2){__uint_as_float((unsigned)NX[0]), __uint_as_float((unsigned)(NX[0] >> 32))}; \
      const unsigned lo_ = (unsigned)NX[5], hi_ = (unsigned)(NX[5] >> 32);                                              \
      *(f32x4*)(REC + pp_ * 768 + 576 + 4 * k_) = (f32x4){bf_lo(lo_), bf_hi(lo_), bf_lo(hi_), bf_hi(hi_)};              \
    }                                                                                                                   \
    _Pragma("unroll") for (int n = 0; n < 4; ++n) {                                                                     \
      const int idx_ = n * 256 + tid, pp_ = idx_ >> 7, vec_ = (idx_ >> 4) & 7, k_ = idx_ & 15;                          \
      const unsigned lo_ = (unsigned)NX[1 + n], hi_ = (unsigned)(NX[1 + n] >> 32);                                      \
      *(f32x4*)(REC + pp_ * 768 + rec_voff(vec_) + 4 * k_) = (f32x4){bf_lo(lo_), bf_hi(lo_), bf_lo(hi_), bf_hi(hi_)};   \
    }                                                                                                                   \
    if (tid < 16) *(f32x2*)(REC + (tid >> 1) * 768 + 704 + 2 * (tid & 1)) = (f32x2){__uint_as_float((unsigned)NX[6]), __uint_as_float((unsigned)(NX[6] >> 32))}; \
  }
  if (tid == 0) PC_WAIT(flag_ld(FLAG_PROD(chain, 0)) < 1u);
  __syncthreads();
  CONS_ISSUE(nxA, 0)
  CONS_INSTALL(nxA)
  if (tid == 0) PC_WAIT(flag_ld(FLAG_PROD(chain, 1 % NPROD)) < 2u);
  __syncthreads();
  CONS_ISSUE(nxA, 1)
  unsigned fnext = 0u;
  if (tid == 0) fnext = flag_ld(FLAG_PROD(chain, 2 % NPROD));
#define CONS_FETCH(PP, BUF)                                                                                             \
  {                                                                                                                     \
    const float* Rb_ = REC + (PP) * 768;                                                                                \
    _Pragma("unroll") for (int f = 0; f < 9; ++f) L[BUF][f] = *(const f32x4*)(Rb_ + f * 64 + 4 * g);                    \
    vv[BUF] = *(const f32x2*)(Rb_ + 576 + (split * RPB + rowb0) * 2);                                                   \
    sc[BUF] = *(const f32x4*)(Rb_ + 704);                                                                               \
  }
#define CONS_ITER(CH, NXC, NXN)                                                                                         \
  {                                                                                                                     \
    const int ch = (CH);                                                                                                \
      \
    if (tid == 0 && ch + 3 < 272) fnext = flag_ld(FLAG_PROD(chain, (ch + 3) % NPROD));                                  \
    if (ch + 2 < 272) CONS_ISSUE(NXN, ch + 2)    \
    {                                                                                                                   \
      f32x4 L[2][9]; f32x2 vv[2]; f32x4 sc[2];                                                                          \
      CONS_FETCH(0, 0)                                                                                                  \
      _Pragma("unroll") for (int pp = 0; pp < 8; ++pp) {                                                                \
        const int cbf = pp & 1;                                                                                         \
        if (pp < 7) CONS_FETCH(pp + 1, cbf ^ 1)                                                                         \
        const f32x4 KA = L[cbf][0], P1 = L[cbf][1], P2 = L[cbf][2], W2 = L[cbf][3], B1 = L[cbf][4], K1 = L[cbf][5];     \
        const f32x4 BB = L[cbf][6], KBv = L[cbf][7], RB = L[cbf][8];                                                    \
        const float va = vv[cbf][0], vb = vv[cbf][1];                                                                   \
        f32x2 e1 = S0 * KA.xy; e1 += S1 * KA.zw;                                                                        \
        f32x2 e2 = S0 * P1.xy; e2 += S1 * P1.zw;                                                                        \
        f32x2 e3 = S0 * P2.xy; e3 += S1 * P2.zw;                                                                        \
        float sa_a = e1[0] + e1[1], raw2 = e2[0] + e2[1];                                                               \
        const float d3 = e3[0] + e3[1];                                                                                 \
        red16x2(sa_a, raw2);                                                                                            \
        const f32x2 va2 = {va, va}, vb2 = {vb, vb}, saa2 = {sa_a, sa_a};                                                \
        f32x2 pre0 = S0 * W2.xy + (va2 * K1.xy - saa2 * B1.xy) + vb2 * KBv.xy;                                          \
        f32x2 pre1 = S1 * W2.zw + (va2 * K1.zw - saa2 * B1.zw) + vb2 * KBv.zw;                                          \
        const float sa_b = raw2 - sa_a * sc[cbf][0] + va * sc[cbf][1];                                                  \
        const f32x2 sab2 = {sa_b, sa_b};                                                                                \
        S0 = pre0 - sab2 * BB.xy;                                                                                       \
        S1 = pre1 - sab2 * BB.zw;                                                                                       \
        const float fix = (g == 0) ? (va * sc[cbf][3] - sa_a * sc[cbf][2]) : 0.f;                                       \
        f32x2 yb2 = S0 * RB.xy; yb2 += S1 * RB.zw;                                                                      \
        YB[(2 * pp) * YPT + rowb0 * LPR + g] = d3 + fix;                                                                \
        YB[(2 * pp + 1) * YPT + rowb0 * LPR + g] = yb2[0] + yb2[1];                                                     \
      }                                                                                                                 \
    }                                                                                                                   \
    __syncthreads();                                                                                                    \
    {                                                                                                                   \
      const float* yp = YB + t1 * YPT + q * LPR;                                                                        \
      float a = 0.f;                                                                                                    \
      _Pragma("unroll") for (int k4 = 0; k4 < LPR / 4; ++k4) { const f32x4 v = *(const f32x4*)(yp + 4 * k4); a += (v[0] + v[1]) + (v[2] + v[3]); } \
      const unsigned orow = (unsigned)(d * MROWS + b * TT + scan_tok(ch * 16 + t1, d));                                 \
      YR[(size_t)orow * 512 + h * 64 + split * RPB + q] = bf1(a);                                                       \
    }                                                                                                                   \
    if (ch + 1 < 272) CONS_INSTALL(NXC)                                                                                 \
    if (tid == 0 && ch + 3 < 272 && fnext < (unsigned)(ch + 4)) PC_WAIT(flag_ld(FLAG_PROD(chain, (ch + 3) % NPROD)) < (unsigned)(ch + 4)); \
    __syncthreads();                                                                                                    \
    if (ch + 1 < 272 && tid == 0) flag_st(FLAG_CONS(chain, split), (unsigned)(ch + 2));     \
  }
  if (tid == 0 && fnext < 3u) PC_WAIT(flag_ld(FLAG_PROD(chain, 2 % NPROD)) < 3u);
  __syncthreads();
  for (int c2i = 0; c2i < 272; c2i += 2) {
    CONS_ITER(c2i, nxA, nxB)
    CONS_ITER(c2i + 1, nxB, nxA)
  }
#undef CONS_ISSUE
#undef CONS_INSTALL
#undef CONS_FETCH
#undef CONS_ITER
  __builtin_amdgcn_s_setprio(0);
}

DI void phase_mixer0(const Params& p, char* smem, int vb, int nvb) {
  constexpr int NROLE = 256 + 64 * NPROD;
  __shared__ int s_item;
  if (vb < 256) scan_consumer(p, smem, vb & 63, vb >> 6);
  else if (vb < NROLE) scan_producer(p, smem, (vb - 256) & 63, (vb - 256) >> 6);
  unsigned* ctr = (unsigned*)(p.ws + OFF_FLAGS) + 385 * 64;
  for (;;) {
    __syncthreads();
    if (threadIdx.x == 0) s_item = (int)__hip_atomic_fetch_add(ctr, 1u, __ATOMIC_RELAXED, __HIP_MEMORY_SCOPE_AGENT);
    __syncthreads();
    const int it = s_item;
    if (it >= 1088) break;
    if (it < 1024) {
      const int b = it >> 8, head = (it >> 5) & 7, qb = it & 31;
      attn_block(p, smem, 512, 2, b, head, qb * 128, 0, 68, 0, 0, false, false, 0.f);
    } else {
      const int j = it - 1024;
      const int b = j >> 4, head = (j >> 1) & 7, qb = j & 1;
      attn_block(p, smem, 512, 2, b, head, 4096 + qb * 128, 64, 4, 0, 0, false, false, 0.f);
    }
  }
}

DI void phase_combine(const Params& p, int vb, int nvb) {
  const u16* YR = (const u16*)(p.ws + OFF_OB);
  const u16* VSH = (const u16*)(p.ws + OFF_VSH);
  const float* BONS = (const float*)(p.ws + OFF_BONS);
  const u16* G = (const u16*)(p.ws + OFF_G);
  u16* A2 = (u16*)(p.ws + OFF_HX);
  const int q = threadIdx.x & 15, pi = threadIdx.x >> 4;
  for (int u = vb; u < MROWS * 8 / 16; u += nvb) {
    const int pair = u * 16 + pi;
    const size_t row = (size_t)(pair >> 3); const int h = pair & 7;
    const int col = h * 64 + 4 * q;
    const f32x4 gnw = *(const f32x4*)(p.gn_w_b + col), gnb = *(const f32x4*)(p.gn_b_b + col);
    const u32x2 vu = *(const u32x2*)(VSH + row * 512 + col);
    const float v0 = bf_lo(vu.x), v1 = bf_hi(vu.x), v2 = bf_lo(vu.y), v3 = bf_hi(vu.y);
    float a0 = 0.f, a1 = 0.f, a2 = 0.f, a3 = 0.f;
#pragma unroll
    for (int d = 0; d < 2; ++d) {
      const u32x2 yu = *(const u32x2*)(YR + ((size_t)d * MROWS + row) * 512 + col);
      const float y0 = bf_lo(yu.x), y1 = bf_hi(yu.x), y2 = bf_lo(yu.y), y3 = bf_hi(yu.y);
      const float mean = reduce16((y0 + y1) + (y2 + y3)) * (1.f / 64.f);
      const float d0 = y0 - mean, d1 = y1 - mean, d2 = y2 - mean, d3 = y3 - mean;
      const float var = reduce16(d0 * d0 + d1 * d1 + d2 * d2 + d3 * d3) * (1.f / 64.f);
      const float rstd = rsqrtf(var + 64e-5f);
      const float bon = BONS[((size_t)d * MROWS + row) * 8 + h];
      a0 += d0 * rstd * gnw[0] + gnb[0] + bon * v0; a1 += d1 * rstd * gnw[1] + gnb[1] + bon * v1;
      a2 += d2 * rstd * gnw[2] + gnb[2] + bon * v2; a3 += d3 * rstd * gnw[3] + gnb[3] + bon * v3;
    }
    const u32x2 gq = *(const u32x2*)(G + row * 1024 + 512 + col);
    *(u32x2*)(A2 + row * 1024 + 512 + col) = mk2(pk2(a0 * bf_lo(gq.x), a1 * bf_hi(gq.x)), pk2(a2 * bf_lo(gq.y), a3 * bf_hi(gq.y)));
  }
}

DI void phase_post(const Params& p, int vb, int nvb) {
  const int tid = threadIdx.x, lane = tid & 63, w = tid >> 6;
  const float* MOD = (const float*)(p.ws + OFF_MOD);
  const u16* Y = (const u16*)(p.ws + OFF_Y);
  u16* HX = (u16*)(p.ws + OFF_HX);
  for (int u = vb; u < MROWS / 4; u += nvb) {
    const int rowg = u * 4 + w;
    const int b = rowg / TT, tok = rowg - b * TT;
    const bool lat = tok < 4096;
    const float* src = lat ? p.x + ((size_t)b * 4096 + tok) * 1024 : p.ctx + ((size_t)b * 256 + (tok - 4096)) * 1024;
    const float* mod0 = MOD + (0 * 5 + (lat ? b : 4)) * 3072;
    const float* mod1 = MOD + (1 * 5 + (lat ? b : 4)) * 3072;
    f32x4 yv[4]; float ss = 0.f;
#pragma unroll
    for (int j = 0; j < 4; ++j) { const u32x2 yu = *(const u32x2*)(Y + (size_t)rowg * 1024 + j * 256 + lane * 4); yv[j] = (f32x4){bf_lo(yu.x), bf_hi(yu.x), bf_lo(yu.y), bf_hi(yu.y)}; ss += yv[j][0] * yv[j][0] + yv[j][1] * yv[j][1] + yv[j][2] * yv[j][2] + yv[j][3] * yv[j][3]; }
    ss = wave_sum(ss);
    const float rinv = rsqrtf(ss * (1.f / 1024.f) + 1e-6f);
    f32x4 x1[4]; float s1 = 0.f;
#pragma unroll
    for (int j = 0; j < 4; ++j) {
      const int col = j * 256 + lane * 4;
      const f32x4 xv = __builtin_nontemporal_load((const f32x4*)(src + col)), gp = *(const f32x4*)(p.g_post + col), gt = *(const f32x4*)(mod0 + 2048 + col);
#pragma unroll
      for (int e = 0; e < 4; ++e) { x1[j][e] = xv[e] + gt[e] * (yv[j][e] * rinv * gp[e]); s1 += x1[j][e] * x1[j][e]; }
      if (lat) *(u32x2*)((u16*)(p.ws + OFF_OB) + ((size_t)b * 4096 + tok) * 1024 + col) = mk2(pk2(x1[j][0], x1[j][1]), pk2(x1[j][2], x1[j][3]));
    }
    s1 = wave_sum(s1);
    const float rinv1 = rsqrtf(s1 * (1.f / 1024.f) + 1e-6f);
#pragma unroll
    for (int j = 0; j < 4; ++j) {
      const int col = j * 256 + lane * 4;
      const f32x4 g = *(const f32x4*)(p.g_pre + 1024 + col), sh = *(const f32x4*)(mod1 + col), scv = *(const f32x4*)(mod1 + 1024 + col);
      float hv[4];
#pragma unroll
      for (int e = 0; e < 4; ++e) hv[e] = (x1[j][e] * rinv1 * g[e]) * (1.f + scv[e]) + sh[e];
      *(u32x2*)(HX + (size_t)rowg * 1024 + col) = mk2(pk2(hv[0], hv[1]), pk2(hv[2], hv[3]));
    }
  }
}

DI void phase_attn1(const Params& p, char* smem, int vb, int nvb) {
  for (int it = vb; it < 2048; it += nvb) {
    const int b = it >> 9, head = (it >> 5) & 15, qb = it & 31;
    const int q0 = qb * 128;
    const int lo = (q0 - 128 < 0) ? 0 : q0 - 128, hi = (q0 + 256 > 4096) ? 4096 : q0 + 256;
    attn_block(p, smem, 1024, 4, b, head, q0, 64, 4, lo >> 6, (hi - lo) >> 6, true, true, p.sink_c[head] * 1.4426950408889634f);
  }
}

DI void phase_final(const Params& p, int vb, int nvb) {
  const int tid = threadIdx.x, lane = tid & 63, w = tid >> 6;
  const float* MOD = (const float*)(p.ws + OFF_MOD);
  const u16* Y = (const u16*)(p.ws + OFF_Y);
  for (int u = vb; u < 4096; u += nvb) {
    const int rowl = u * 4 + w;
    const int b = rowl >> 12, tok = rowl & 4095;
    const size_t rowg = (size_t)b * TT + tok;
    const float* mod1 = MOD + (1 * 5 + b) * 3072;
    f32x4 yv[4]; float ss = 0.f;
#pragma unroll
    for (int j = 0; j < 4; ++j) { const u32x2 yu = *(const u32x2*)(Y + rowg * 1024 + j * 256 + lane * 4); yv[j] = (f32x4){bf_lo(yu.x), bf_hi(yu.x), bf_lo(yu.y), bf_hi(yu.y)}; ss += yv[j][0] * yv[j][0] + yv[j][1] * yv[j][1] + yv[j][2] * yv[j][2] + yv[j][3] * yv[j][3]; }
    ss = wave_sum(ss);
    const float rinv = rsqrtf(ss * (1.f / 1024.f) + 1e-6f);
#pragma unroll
    for (int j = 0; j < 4; ++j) {
      const int col = j * 256 + lane * 4;
      float* op = p.out + (size_t)rowl * 1024 + col;
      const u32x2 xu = *(const u32x2*)((const u16*)(p.ws + OFF_OB) + (size_t)rowl * 1024 + col);
      const f32x4 xv = {bf_lo(xu.x), bf_hi(xu.x), bf_lo(xu.y), bf_hi(xu.y)}, gp = *(const f32x4*)(p.g_post + 1024 + col), gt = *(const f32x4*)(mod1 + 2048 + col);
      f32x4 ov;
#pragma unroll
      for (int e = 0; e < 4; ++e) ov[e] = xv[e] + gt[e] * (yv[j][e] * rinv * gp[e]);
      __builtin_nontemporal_store(ov, (f32x4*)op);
    }
  }
}

#ifndef PHMASK
#define PHMASK 0x7ff
#endif
#ifndef LB2
#define LB2 2
#endif
#define PH_ON(i) (((PHMASK) >> (i)) & 1)
static constexpr int SMEM_BYTES = 73728;
__global__ void __launch_bounds__(256, LB2) hybrid_fwd(Params p) {
  extern __shared__ __attribute__((aligned(16))) char smem[];
  __shared__ u32x4 xb_words;
  cg::grid_group grid = cg::this_grid();
  const int vb = blockIdx.x, nvb = gridDim.x;
  XcdBarrier xb; xb.bar = (unsigned*)(p.ws + OFF_BAR); xb.x = 0; xb.st = (volatile LAS unsigned*)&xb_words;
  if (p.ph_hi - p.ph_lo > 1) {
    if (threadIdx.x == 0) xb_words = (u32x4){0u, 0u, 0u, 0u};
    __syncthreads();
    xb = xcd_barrier_post((unsigned*)(p.ws + OFF_BAR), (volatile LAS unsigned*)&xb_words);
  }
#ifndef DUP_PH
#define DUP_PH -1
#endif
#define RUN_PH(i, call)                                            \
  if (PH_ON(i) && p.ph_lo <= (i) && (i) < p.ph_hi) { call; if ((i) == DUP_PH) { __syncthreads(); call; } }         \
  if (p.ph_lo <= (i) && (i) + 1 < p.ph_hi) { if (p.ph_hi > 1000) grid.sync(); else xcd_barrier(xb); }
#ifdef EXTRA_SYNC
  for (int es = 0; es < EXTRA_SYNC; ++es) grid.sync();
#endif
  RUN_PH(0, phase_prep(p, smem, vb, nvb))
  int vid = vb;
  if (p.ph_hi - p.ph_lo > 1) {
    if (threadIdx.x == 0) {
      unsigned base = 0u;
#pragma unroll
      for (unsigned j = 0; j < 16; ++j) { const unsigned c = xb_ld(&xb.bar[XB_XCNT(j)]); base += (j < xb.x) ? c : 0u; }
      xb.st[3] = base + xb.st[2];
    }
    __syncthreads();
    vid = (int)xb.st[3];
  }
  RUN_PH(1, phase_prenorm0(p, vb, nvb))
  RUN_PH(2, gemm_phase<0>(p, smem, vb, nvb, (const u16*)(p.ws + OFF_WT0), (const u16*)(p.ws + OFF_HX), 28))
  RUN_PH(3, phase_mixer0(p, smem, vb, nvb))
  RUN_PH(4, phase_combine(p, vb, nvb))
  RUN_PH(5, gemm_phase<1>(p, smem, vb, nvb, (const u16*)(p.ws + OFF_WT1), (const u16*)(p.ws + OFF_HX), 8))
  RUN_PH(6, phase_post(p, vb, nvb))
  RUN_PH(7, gemm_phase<2>(p, smem, vb, nvb, (const u16*)(p.ws + OFF_WT2), (const u16*)(p.ws + OFF_HX), 20))
  RUN_PH(8, phase_attn1(p, smem, vb, nvb))
  RUN_PH(9, gemm_phase<3>(p, smem, vb, nvb, (const u16*)(p.ws + OFF_WT3), (const u16*)(p.ws + OFF_HX), 8))
  RUN_PH(10, phase_final(p, vb, nvb))
#undef RUN_PH
}

extern "C" void kernel_launch(void* const* d_in, const int* in_sizes, int n_in, void* d_out, int out_size, void* d_ws, size_t ws_size, hipStream_t stream) {
  static int grid_blocks = 0;
  if (grid_blocks == 0) {
    if (n_in != 27 || ws_size < WS_END) { fprintf(stderr, "kernel_launch: expected 27 inputs and >= %zu bytes of workspace (got %d, %zu)\n", (size_t)WS_END, n_in, ws_size); grid_blocks = -1; return; }
    int dev = 0, cus = 0, per_cu = 0;
    hipGetDevice(&dev);
    hipDeviceGetAttribute(&cus, hipDeviceAttributeMultiprocessorCount, dev);
    hipFuncSetAttribute((const void*)hybrid_fwd, hipFuncAttributeMaxDynamicSharedMemorySize, SMEM_BYTES);
    hipOccupancyMaxActiveBlocksPerMultiprocessor(&per_cu, hybrid_fwd, 256, SMEM_BYTES);
    if (per_cu < 1) per_cu = 1;
    if (per_cu > 2) per_cu = 2;
    grid_blocks = cus * per_cu;
    if (grid_blocks < 512) { fprintf(stderr, "kernel_launch: needs 512 co-resident blocks, got %d\n", grid_blocks); grid_blocks = -1; return; }
    grid_blocks = 512;
    fprintf(stderr, "kernel_launch: cus %d per_cu %d grid %d\n", cus, per_cu, grid_blocks);
  }
  if (grid_blocks < 0) return;
  Params p;
  memset(&p, 0, sizeof(p));
  const float** pp = (const float**)&p;
  for (int i = 0; i < 27; ++i) pp[i] = (const float*)d_in[i];
  p.out = (float*)d_out;
  p.ws = (unsigned char*)d_ws;
#if N_LAUNCH_MODE == 1
  p.ph_lo = 0; p.ph_hi = NPH;
  hipMemsetAsync((unsigned char*)d_ws + OFF_BAR, 0, 16384 + 131072, stream);
  void* args[] = {&p};
  hipError_t e = hipLaunchCooperativeKernel((void*)hybrid_fwd, dim3(grid_blocks), dim3(256), args, SMEM_BYTES, stream);
  if (e != hipSuccess) fprintf(stderr, "cooperative launch failed: %s (grid %d)\n", hipGetErrorString(e), grid_blocks);
#else
  for (int ph = 0; ph < NPH; ++ph) {
    p.ph_lo = ph; p.ph_hi = ph + 1;
    hipLaunchKernelGGL(hybrid_fwd, dim3(grid_blocks), dim3(256), SMEM_BYTES, stream, p);
  }
#endif
}
```

```cpp
#include <hip/hip_runtime.h>
#include <hip/hip_cooperative_groups.h>
#include <cstdio>
#include <cstdint>
#include <cstring>
namespace cg = cooperative_groups;

#ifndef N_LAUNCH_MODE
#define N_LAUNCH_MODE 1
#endif

typedef __attribute__((ext_vector_type(8))) short bf16x8;
typedef __attribute__((ext_vector_type(4))) short s16x4;
typedef __attribute__((ext_vector_type(4))) float f32x4;
typedef __attribute__((ext_vector_type(2))) float f32x2;
typedef __attribute__((ext_vector_type(16))) float f32x16;
typedef __attribute__((ext_vector_type(2))) __bf16 bf16x2_t;
typedef unsigned short u16;
typedef __attribute__((ext_vector_type(4))) unsigned u32x4;
typedef __attribute__((ext_vector_type(2))) unsigned u32x2;
#define DI __device__ __forceinline__
#define MFMA32(a, b, c) __builtin_amdgcn_mfma_f32_32x32x16_bf16((a), (b), (c), 0, 0, 0)
#define MFMA16(a, b, c) __builtin_amdgcn_mfma_f32_16x16x32_bf16((a), (b), (c), 0, 0, 0)

static constexpr int TT = 4352;
static constexpr int MROWS = 4 * TT;
static constexpr int NPH = 11;

static constexpr size_t OFF_WT0 = 0;
static constexpr size_t OFF_WT1 = OFF_WT0 + 7340032;
static constexpr size_t OFF_WT2 = OFF_WT1 + 2097152;
static constexpr size_t OFF_WT3 = OFF_WT2 + 5242880;
static constexpr size_t OFF_MOD = OFF_WT3 + 2097152;
static constexpr size_t OFF_HX  = OFF_MOD + 131072;
static constexpr size_t OFF_Q   = OFF_HX + 35651584;
static constexpr size_t OFF_KB  = OFF_Q + 35651584;
static constexpr size_t OFF_VT  = OFF_KB + 8912896;
static constexpr size_t OFF_PB  = OFF_VT + 8912896;
static constexpr size_t OFF_G   = OFF_PB + 62390272;
static constexpr size_t OFF_OB  = OFF_G + 35651584;
static constexpr size_t OFF_VSH = OFF_OB + 35651584;
static constexpr size_t OFF_BONS = OFF_VSH + 17825792;
static constexpr size_t OFF_BAR = OFF_BONS + 1114112;
static constexpr size_t OFF_FLAGS = OFF_BAR + 16384;
static constexpr size_t WS_END  = OFF_FLAGS + 131072;
static constexpr size_t OFF_Y   = OFF_PB;

struct Params {
  const float *x, *c, *ctx, *c_ctx, *w_mod, *b_mod, *g_pre, *g_post, *w_in_even, *w_out_even, *qn_a, *kn_a,
      *mu_b, *w0_b, *w2_b, *a0_b, *a2_b, *kk_b, *ka_b, *rk_b, *gn_w_b, *gn_b_b, *w_in_odd, *w_out_odd, *qn_c, *kn_c, *sink_c;
  float* out;
  unsigned char* ws;
  int ph_lo, ph_hi;
};

DI u32x4 mk4(unsigned a, unsigned b, unsigned c, unsigned d) { u32x4 v = {a, b, c, d}; return v; }
DI u32x2 mk2(unsigned a, unsigned b) { u32x2 v = {a, b}; return v; }
DI unsigned pk2(float lo, float hi) { f32x2 v = {lo, hi}; bf16x2_t b = __builtin_convertvector(v, bf16x2_t); return __builtin_bit_cast(unsigned, b); }
DI u16 bf1(float x) { return (u16)(pk2(x, 0.f) & 0xffffu); }
DI float bf_lo(unsigned u) { return __uint_as_float(u << 16); }
DI float bf_hi(unsigned u) { return __uint_as_float(u & 0xffff0000u); }
template <int CTRL> DI float dppf(float x) { return __int_as_float(__builtin_amdgcn_update_dpp(0, __float_as_int(x), CTRL, 0xF, 0xF, true)); }
DI float reduce16(float x) { x += dppf<0xB1>(x); x += dppf<0x4E>(x); x += dppf<0x124>(x); x += dppf<0x128>(x); return x; }
DI float reduce8(float x) { x += dppf<0xB1>(x); x += dppf<0x4E>(x); x += dppf<0x141>(x); return x; }
DI float wave_sum(float x) { for (int o = 32; o >= 1; o >>= 1) x += __shfl_xor(x, o); return x; }
DI float silu(float v) { return v / (1.f + __expf(-v)); }
DI float fexp2(float x) { return __builtin_amdgcn_exp2f(x); }


#define XB_TMO      128
#define XB_XCNT(j)  (256  + 64 * (j))
#define XB_XSUB(j)  (1280 + 64 * (j))
#define XB_XGEN(j)  (2304 + 64 * (j))
#define XB_TOP      3328
#define XB_TOPGEN   3392
#define XCD_BAR_WORDS 3456
#define XB_SPIN_CAP (1u << 20)
#define LAS __attribute__((address_space(3)))
DI unsigned xb_ld(unsigned* p) { return __hip_atomic_load(p, __ATOMIC_RELAXED, __HIP_MEMORY_SCOPE_AGENT); }
DI unsigned xb_add(unsigned* p, unsigned v) { return __hip_atomic_fetch_add(p, v, __ATOMIC_RELAXED, __HIP_MEMORY_SCOPE_AGENT); }
DI unsigned xb_xcc_id() { return (unsigned)__builtin_amdgcn_s_getreg((3 << 11) | 20) & 0xFu; }
#define XB_SPIN(cond, bar) do { unsigned _sp = 0; while (cond) { __builtin_amdgcn_s_sleep(1); \
    if ((++_sp & 255u) == 0u) { if (xb_ld(&(bar)[XB_TMO])) break; if (_sp > XB_SPIN_CAP) { atomicAdd(&(bar)[XB_TMO], 1u); break; } } } } while (0)
struct XcdBarrier { unsigned* bar; unsigned x; volatile LAS unsigned* st; };
DI XcdBarrier xcd_barrier_post(unsigned* bar, volatile LAS unsigned* st) {
  XcdBarrier b; b.bar = bar; b.x = xb_xcc_id(); b.st = st;
  if (threadIdx.x == 0) st[2] = xb_add(&bar[XB_XCNT(b.x)], 1u);
  return b;
}
DI void xcd_barrier_complete(unsigned* bar, unsigned x, unsigned& nloc, unsigned& nx) {
  const unsigned G = gridDim.x * gridDim.y * gridDim.z;
  unsigned sum, cnt, mine, sp = 0u;
  for (;;) {
    sum = 0u; cnt = 0u; mine = 0u;
#pragma unroll
    for (unsigned j = 0; j < 16; ++j) { const unsigned c = xb_ld(&bar[XB_XCNT(j)]); sum += c; cnt += (c > 0u) ? 1u : 0u; mine = (j == x) ? c : mine; }
    if (sum == G) break;
    __builtin_amdgcn_s_sleep(1);
    if ((++sp & 255u) == 0u) { if (xb_ld(&bar[XB_TMO])) break; if (sp > XB_SPIN_CAP) { atomicAdd(&bar[XB_TMO], 1u); break; } }
  }
  nloc = mine > 0u ? mine : 1u; nx = cnt > 0u ? cnt : 1u;
}
DI void xcd_barrier(const XcdBarrier& b) {
  asm volatile("s_waitcnt vmcnt(0)" ::: "memory");
  __syncthreads();
  if (threadIdx.x == 0) {
    unsigned* bar = b.bar;
    __builtin_amdgcn_s_waitcnt(0);
    unsigned nloc = b.st[0], nx = b.st[1];
    if (nloc == 0u) { xcd_barrier_complete(bar, b.x, nloc, nx); b.st[0] = nloc; b.st[1] = nx; }
    const unsigned old = xb_add(&bar[XB_XSUB(b.x)], 1u);
    const unsigned gen = old / nloc;
    if (old + 1u == (gen + 1u) * nloc) {
      __builtin_amdgcn_fence(__ATOMIC_RELEASE, "agent");
      asm volatile("s_waitcnt vmcnt(0)" ::: "memory");
      const unsigned og = xb_add(&bar[XB_TOP], 1u);
      const unsigned tg = og / nx;
      if (og + 1u == (tg + 1u) * nx) xb_add(&bar[XB_TOPGEN], 1u);
      else XB_SPIN(xb_ld(&bar[XB_TOPGEN]) == tg, bar);
      __builtin_amdgcn_fence(__ATOMIC_ACQUIRE, "agent");
      xb_add(&bar[XB_XGEN(b.x)], 1u);
      asm volatile("s_waitcnt vmcnt(0)" ::: "memory");
    } else {
      XB_SPIN(xb_ld(&bar[XB_XGEN(b.x)]) == gen, bar);
      __builtin_amdgcn_fence(__ATOMIC_ACQUIRE, "agent");
      asm volatile("s_waitcnt vmcnt(0)" ::: "memory");
    }
  }
  __syncthreads();
}

#define DPP_ADD(name, ctrl) DI float name(float x) { float r; asm("s_nop 1\n\tv_add_f32_dpp %0, %1, %1 " ctrl " row_mask:0xf bank_mask:0xf" : "=v"(r) : "v"(x)); return r; }
DPP_ADD(dpa_x1, "quad_perm:[1,0,3,2]")
DPP_ADD(dpa_x2, "quad_perm:[2,3,0,1]")
DPP_ADD(dpa_hm, "row_half_mirror")
DPP_ADD(dpa_r4, "row_ror:4")
DPP_ADD(dpa_r8, "row_ror:8")
template <int LPR> DI float red_lpr(float x) {
  x = dpa_x1(x); x = dpa_x2(x);
  if (LPR == 8) x = dpa_hm(x); else { x = dpa_r4(x); x = dpa_r8(x); }
  return x;
}

DI void phase_prep(const Params& p, char* smem, int vb, int nvb) {
  const int tid = threadIdx.x;
  float* tile = (float*)smem;
  float* sc = (float*)smem;
  float* part = sc + 5120;
  for (int u = vb; u < 2048 + 384; u += nvb) {
    if (u < 2048) {
      int ti = u; const float* W; u16* Wt; int N;
      if (ti < 896) { W = p.w_in_even; Wt = (u16*)(p.ws + OFF_WT0); N = 3584; }
      else if (ti < 1152) { ti -= 896; W = p.w_out_even; Wt = (u16*)(p.ws + OFF_WT1); N = 1024; }
      else if (ti < 1792) { ti -= 1152; W = p.w_in_odd; Wt = (u16*)(p.ws + OFF_WT2); N = 2560; }
      else { ti -= 1792; W = p.w_out_odd; Wt = (u16*)(p.ws + OFF_WT3); N = 1024; }
      const int ntn = N >> 6;
      const int kt = ti / ntn, nt = ti - kt * ntn;
#pragma unroll
      for (int ps = 0; ps < 4; ++ps) {
        const int row = (tid >> 4) + 16 * ps, c4 = (tid & 15) * 4;
        const f32x4 v = *(const f32x4*)(W + (size_t)(kt * 64 + row) * N + nt * 64 + c4);
        tile[row * 65 + c4 + 0] = v[0]; tile[row * 65 + c4 + 1] = v[1]; tile[row * 65 + c4 + 2] = v[2]; tile[row * 65 + c4 + 3] = v[3];
      }
      __syncthreads();
      const int n = tid >> 2, kq = (tid & 3) * 16;
      unsigned o[8];
#pragma unroll
      for (int j = 0; j < 8; ++j) o[j] = pk2(tile[(kq + 2 * j) * 65 + n], tile[(kq + 2 * j + 1) * 65 + n]);
      u32x4* dst = (u32x4*)(Wt + (size_t)(nt * 64 + n) * 1024 + kt * 64 + kq);
      dst[0] = mk4(o[0], o[1], o[2], o[3]);
      dst[1] = mk4(o[4], o[5], o[6], o[7]);
      __syncthreads();
    } else {
      const int u2 = u - 2048;
      const int l = u2 / 192, cb = u2 - l * 192;
      for (int idx = tid; idx < 5120; idx += 256) {
        const int s = idx >> 10, k = idx & 1023;
        const float v = (s < 4) ? p.c[s * 1024 + k] : p.c_ctx[k];
        sc[idx] = v / (1.f + expf(-v));
      }
      __syncthreads();
      const int col = tid & 15, kg = tid >> 4;
      float acc[5] = {0.f, 0.f, 0.f, 0.f, 0.f};
      const float* wp = p.w_mod + ((size_t)l * 1024 + kg * 64) * 3072 + cb * 16 + col;
#pragma unroll 16
      for (int k = 0; k < 64; ++k) {
        const float wv = wp[(size_t)k * 3072];
#pragma unroll
        for (int s = 0; s < 5; ++s) acc[s] += sc[s * 1024 + kg * 64 + k] * wv;
      }
#pragma unroll
      for (int s = 0; s < 5; ++s) part[(kg * 5 + s) * 16 + col] = acc[s];
      __syncthreads();
      if (tid < 80) {
        const int s = tid >> 4, cc = tid & 15;
        float a = 0.f;
        for (int g = 0; g < 16; ++g) a += part[(g * 5 + s) * 16 + cc];
        float* MOD = (float*)(p.ws + OFF_MOD);
        MOD[(l * 5 + s) * 3072 + cb * 16 + cc] = a + p.b_mod[l * 3072 + cb * 16 + cc];
      }
      __syncthreads();
    }
  }
}

DI void phase_prenorm0(const Params& p, int vb, int nvb) {
  const int tid = threadIdx.x, lane = tid & 63, w = tid >> 6;
  const float* MOD = (const float*)(p.ws + OFF_MOD);
  u16* HX = (u16*)(p.ws + OFF_HX);
  for (int u = vb; u < MROWS / 4; u += nvb) {
    const int rowg = u * 4 + w;
    const int b = rowg / TT, tok = rowg - b * TT;
    const bool lat = tok < 4096;
    const float* src = lat ? p.x + ((size_t)b * 4096 + tok) * 1024 : p.ctx + ((size_t)b * 256 + (tok - 4096)) * 1024;
    const float* mod = MOD + (0 * 5 + (lat ? b : 4)) * 3072;
    f32x4 v[4]; float ss = 0.f;
#pragma unroll
    for (int j = 0; j < 4; ++j) { v[j] = __builtin_nontemporal_load((const f32x4*)(src + j * 256 + lane * 4)); ss += v[j][0] * v[j][0] + v[j][1] * v[j][1] + v[j][2] * v[j][2] + v[j][3] * v[j][3]; }
    ss = wave_sum(ss);
    const float rinv = rsqrtf(ss * (1.f / 1024.f) + 1e-6f);
#pragma unroll
    for (int j = 0; j < 4; ++j) {
      const int col = j * 256 + lane * 4;
      const f32x4 g = *(const f32x4*)(p.g_pre + col), sh = *(const f32x4*)(mod + col), scv = *(const f32x4*)(mod + 1024 + col);
      float hv[4];
#pragma unroll
      for (int e = 0; e < 4; ++e) hv[e] = (v[j][e] * rinv * g[e]) * (1.f + scv[e]) + sh[e];
      *(u32x2*)(HX + (size_t)rowg * 1024 + col) = mk2(pk2(hv[0], hv[1]), pk2(hv[2], hv[3]));
    }
  }
}

template <int MODE>
DI void gemm_phase(const Params& p, char* smem, int vb, int nvb, const u16* __restrict__ Wt, const u16* __restrict__ X, int NT) {
  u16* As = (u16*)smem;
  u16* Bs = As + 2 * 128 * 72;
  const int tid = threadIdx.x, lane = tid & 63, w = tid >> 6, r = lane & 31, h = lane >> 5;
  const int wn = w & 1, wt = w >> 1;
  const int total = 136 * NT;
  const int NB4 = NT >> 2;
  for (int u = vb; u < total; u += nvb) {
    const int blk = u >> 5, wi = u & 31;
    const int mbk = blk / NB4, nbk = blk - mbk * NB4;
    const int mt = mbk * 8 + (wi >> 2), nt = nbk * 4 + (wi & 3);
    const bool ctx_tile = (mt % 34) >= 32;
    if (MODE == 2 && ctx_tile && (nt < 8 || nt >= 12)) continue;
    if (MODE == 3 && ctx_tile) continue;
    const u16* Wg = Wt + (size_t)(nt * 128) * 1024;
    const u16* Xg = X + (size_t)(mt * 128) * 1024;
    f32x16 acc[2][2];
#pragma unroll
    for (int a = 0; a < 2; ++a)
#pragma unroll
      for (int bq = 0; bq < 2; ++bq)
#pragma unroll
        for (int i = 0; i < 16; ++i) acc[a][bq][i] = 0.f;
    u32x4 ra[4], rb[4];
#define GEMM_LOAD(KT)                                                                                     \
    {                                                                                                     \
      _Pragma("unroll") for (int j = 0; j < 4; ++j) {                                                     \
        const int cidx = tid + 256 * j, row = cidx >> 3, part = cidx & 7;                                 \
        ra[j] = *(const u32x4*)(Wg + (size_t)row * 1024 + (KT) * 64 + part * 8);                          \
        rb[j] = *(const u32x4*)(Xg + (size_t)row * 1024 + (KT) * 64 + part * 8);                          \
      }                                                                                                   \
    }
#define GEMM_STORE(BUF)                                                                                   \
    {                                                                                                     \
      _Pragma("unroll") for (int j = 0; j < 4; ++j) {                                                     \
        const int cidx = tid + 256 * j, row = cidx >> 3, part = cidx & 7;                                 \
        *(u32x4*)(As + (BUF) * 9216 + row * 72 + part * 8) = ra[j];                                      \
        *(u32x4*)(Bs + (BUF) * 9216 + row * 72 + part * 8) = rb[j];                                      \
      }                                                                                                   \
    }
    GEMM_LOAD(0)
    GEMM_STORE(0)
    GEMM_LOAD(1)
    __syncthreads();
    for (int kt = 0; kt < 16; ++kt) {
      const int cbuf = kt & 1;
      const u16* Ac = As + cbuf * 9216;
      const u16* Bc = Bs + cbuf * 9216;
      __builtin_amdgcn_s_setprio(1);
#pragma unroll
      for (int ks = 0; ks < 4; ++ks) {
        const bf16x8 a0 = *(const bf16x8*)(Ac + (wn * 64 + r) * 72 + ks * 16 + h * 8);
        const bf16x8 a1 = *(const bf16x8*)(Ac + (wn * 64 + 32 + r) * 72 + ks * 16 + h * 8);
        const bf16x8 b0 = *(const bf16x8*)(Bc + (wt * 64 + r) * 72 + ks * 16 + h * 8);
        const bf16x8 b1 = *(const bf16x8*)(Bc + (wt * 64 + 32 + r) * 72 + ks * 16 + h * 8);
        acc[0][0] = MFMA32(a0, b0, acc[0][0]);
        acc[0][1] = MFMA32(a0, b1, acc[0][1]);
        acc[1][0] = MFMA32(a1, b0, acc[1][0]);
        acc[1][1] = MFMA32(a1, b1, acc[1][1]);
      }
      __builtin_amdgcn_s_setprio(0);
      __builtin_amdgcn_sched_barrier(0);
      if (kt + 1 < 16) GEMM_STORE(cbuf ^ 1)
      if (kt + 2 < 16) GEMM_LOAD(kt + 2)
      __syncthreads();
    }
#undef GEMM_LOAD
#undef GEMM_STORE
    const int nbase = nt * 128 + wn * 64;
    if (MODE == 1 || MODE == 3) {
      u16* Y = (u16*)(p.ws + OFF_Y);
#pragma unroll
      for (int tb = 0; tb < 2; ++tb) {
        const int rowg = mt * 128 + wt * 64 + tb * 32 + r;
#pragma unroll
        for (int nb = 0; nb < 2; ++nb)
#pragma unroll
          for (int ig = 0; ig < 4; ++ig) {
            *(u32x2*)(Y + (size_t)rowg * 1024 + nbase + nb * 32 + 8 * ig + 4 * h) =
                mk2(pk2(acc[nb][tb][4 * ig], acc[nb][tb][4 * ig + 1]), pk2(acc[nb][tb][4 * ig + 2], acc[nb][tb][4 * ig + 3]));
          }
      }
    } else {
      const int seg = nbase >> 6;
      int kind, hidx, QP, Gn, gateoff; const float* gain;
      if (MODE == 0) {
        QP = 512; Gn = 2;
        if (seg < 8) { kind = 0; hidx = seg; gain = p.qn_a; }
        else if (seg < 10) { kind = 1; hidx = seg - 8; gain = p.kn_a; }
        else if (seg < 12) { kind = 2; hidx = seg - 10; gain = nullptr; }
        else if (seg < 40) { kind = 3; hidx = 0; gain = nullptr; }
        else { kind = 4; hidx = 0; gain = nullptr; }
        gateoff = 2560;
      } else {
        QP = 1024; Gn = 4;
        if (seg < 16) { kind = 0; hidx = seg; gain = p.qn_c; }
        else if (seg < 20) { kind = 1; hidx = seg - 16; gain = p.kn_c; }
        else if (seg < 24) { kind = 2; hidx = seg - 20; gain = nullptr; }
        else { kind = 4; hidx = 0; gain = nullptr; }
        gateoff = 1536;
      }
      u16* Q = (u16*)(p.ws + OFF_Q);
      u16* KB = (u16*)(p.ws + OFF_KB);
      u16* VT = (u16*)(p.ws + OFF_VT);
      u16* PB = (u16*)(p.ws + OFF_PB);
      u16* G = (u16*)(p.ws + OFF_G);
#pragma unroll
      for (int tb = 0; tb < 2; ++tb) {
        const int rowg = mt * 128 + wt * 64 + tb * 32 + r;
        const int b = rowg / TT, tok = rowg - b * TT;
        const bool lat = tok < 4096;
        if (kind <= 1) {
          float ss = 0.f;
#pragma unroll
          for (int nb = 0; nb < 2; ++nb)
#pragma unroll
            for (int i = 0; i < 16; ++i) ss += acc[nb][tb][i] * acc[nb][tb][i];
          ss += __shfl_xor(ss, 32);
          const float rinv = rsqrtf(ss * (1.f / 64.f) + 1e-6f);
          const float prow = (float)(tok >> 6), pcol = (float)(tok & 63);
          const float osc = (kind == 0) ? 0.125f * 1.4426950408889634f : 1.f;
#pragma unroll
          for (int nb = 0; nb < 2; ++nb)
#pragma unroll
            for (int ig = 0; ig < 4; ++ig) {
              const int nin = nb * 32 + 8 * ig + 4 * h;
              const f32x4 gv = *(const f32x4*)(gain + nin);
              float xv[4];
#pragma unroll
              for (int e = 0; e < 4; ++e) xv[e] = acc[nb][tb][4 * ig + e] * rinv * gv[e];
              if (lat) {
#pragma unroll
                for (int pr = 0; pr < 2; ++pr) {
                  const int j = 4 * ig + 2 * h + pr;
                  const float ang = (nb == 0 ? prow : pcol) * exp2f(-(float)j * 0.8304820237218405f);
                  const float cs = __cosf(ang), sn = __sinf(ang);
                  const float x1 = xv[2 * pr], x2 = xv[2 * pr + 1];
                  xv[2 * pr] = x1 * cs - x2 * sn;
                  xv[2 * pr + 1] = x1 * sn + x2 * cs;
                }
              }
              const u32x2 o = mk2(pk2(xv[0] * osc, xv[1] * osc), pk2(xv[2] * osc, xv[3] * osc));
              if (kind == 0) *(u32x2*)(Q + (size_t)rowg * QP + hidx * 64 + nin) = o;
              else *(u32x2*)(KB + ((size_t)(b * Gn + hidx) * TT + tok) * 64 + nin) = o;
            }
        } else if (kind == 2) {
#pragma unroll
          for (int nb = 0; nb < 2; ++nb)
#pragma unroll
            for (int i = 0; i < 16; ++i) {
              const int dd = nb * 32 + (i & 3) + 8 * (i >> 2) + 4 * h;
              VT[((size_t)(b * Gn + hidx) * 64 + dd) * TT + tok] = bf1(acc[nb][tb][i]);
            }
        } else if (kind == 3) {
#pragma unroll
          for (int nb = 0; nb < 2; ++nb)
#pragma unroll
            for (int ig = 0; ig < 4; ++ig)
              *(u32x2*)(PB + (size_t)rowg * 1792 + (nbase - 768) + nb * 32 + 8 * ig + 4 * h) =
                  mk2(pk2(acc[nb][tb][4 * ig], acc[nb][tb][4 * ig + 1]), pk2(acc[nb][tb][4 * ig + 2], acc[nb][tb][4 * ig + 3]));
        } else {
#pragma unroll
          for (int nb = 0; nb < 2; ++nb)
#pragma unroll
            for (int ig = 0; ig < 4; ++ig)
              *(u32x2*)(G + (size_t)rowg * 1024 + (nbase - gateoff) + nb * 32 + 8 * ig + 4 * h) =
                  mk2(pk2(silu(acc[nb][tb][4 * ig]), silu(acc[nb][tb][4 * ig + 1])), pk2(silu(acc[nb][tb][4 * ig + 2]), silu(acc[nb][tb][4 * ig + 3])));
        }
      }
    }
  }
}

DI void attn_block(const Params& p, char* smem, int QP, int Gn, int b, int head, int qtok0,
                   int t_first, int n_first, int t_second, int n_second, bool win, bool has_sink, float sink2) {
  u16* Ks = (u16*)smem;
  u16* Vs = Ks + 64 * 72;
  const u16* Q = (const u16*)(p.ws + OFF_Q);
  const u16* G = (const u16*)(p.ws + OFF_G);
  u16* A2 = (u16*)(p.ws + OFF_HX);
  const int tid = threadIdx.x, lane = tid & 63, w = tid >> 6, r = lane & 31, h = lane >> 5;
  const int g = head >> 2;
  const u16* Kg = (const u16*)(p.ws + OFF_KB) + (size_t)(b * Gn + g) * TT * 64;
  const u16* Vg = (const u16*)(p.ws + OFF_VT) + (size_t)(b * Gn + g) * 64 * TT;
  const int qtok = qtok0 + w * 32 + r;
  const size_t qrow = (size_t)b * TT + qtok;
  bf16x8 qf[4];
#pragma unroll
  for (int ks = 0; ks < 4; ++ks) qf[ks] = *(const bf16x8*)(Q + qrow * QP + head * 64 + ks * 16 + h * 8);
  f32x16 o[2];
#pragma unroll
  for (int db = 0; db < 2; ++db)
#pragma unroll
    for (int i = 0; i < 16; ++i) o[db][i] = 0.f;
  float m = -INFINITY, l = 0.f;
  const int ntot = n_first + n_second;
  u32x4 rk[2], rv[2];
  {
    const int tile = (0 < n_first) ? t_first : t_second;
#pragma unroll
    for (int j = 0; j < 2; ++j) {
      const int cidx = tid + 256 * j, row = cidx >> 3, part = cidx & 7;
      rk[j] = *(const u32x4*)(Kg + (size_t)(tile * 64 + row) * 64 + part * 8);
      rv[j] = *(const u32x4*)(Vg + (size_t)row * TT + tile * 64 + part * 8);
    }
  }
  for (int it = 0; it < ntot; ++it) {
    const int tile = (it < n_first) ? (t_first + it) : (t_second + it - n_first);
    __syncthreads();
#pragma unroll
    for (int j = 0; j < 2; ++j) {
      const int cidx = tid + 256 * j, row = cidx >> 3, part = cidx & 7;
      *(u32x4*)(Ks + row * 72 + part * 8) = rk[j];
      *(u32x4*)(Vs + row * 72 + part * 8) = rv[j];
    }
    __syncthreads();
    if (it + 1 < ntot) {
      const int tn = (it + 1 < n_first) ? (t_first + it + 1) : (t_second + it + 1 - n_first);
#pragma unroll
      for (int j = 0; j < 2; ++j) {
        const int cidx = tid + 256 * j, row = cidx >> 3, part = cidx & 7;
        rk[j] = *(const u32x4*)(Kg + (size_t)(tn * 64 + row) * 64 + part * 8);
        rv[j] = *(const u32x4*)(Vg + (size_t)row * TT + tn * 64 + part * 8);
      }
    }
    __builtin_amdgcn_sched_barrier(0);
    const int qw0 = qtok0 + w * 32;
    const bool live = !win || tile >= 64 || (tile * 64 <= qw0 + 31 + 128 && tile * 64 + 63 >= qw0 - 128);
    if (live) {
    f32x16 s[2];
#pragma unroll
    for (int kb = 0; kb < 2; ++kb) {
#pragma unroll
      for (int i = 0; i < 16; ++i) s[kb][i] = 0.f;
#pragma unroll
      for (int ks = 0; ks < 4; ++ks) {
        const bf16x8 a = *(const bf16x8*)(Ks + (kb * 32 + r) * 72 + ks * 16 + h * 8);
        s[kb] = MFMA32(a, qf[ks], s[kb]);
      }
    }
    if (win && tile < 64) {
#pragma unroll
      for (int kb = 0; kb < 2; ++kb)
#pragma unroll
        for (int i = 0; i < 16; ++i) {
          const int key = tile * 64 + kb * 32 + (i & 3) + 8 * (i >> 2) + 4 * h;
          const int dl = key - qtok;
          if (dl > 128 || dl < -128) s[kb][i] = -INFINITY;
        }
    }
    float mx = -INFINITY;
#pragma unroll
    for (int kb = 0; kb < 2; ++kb)
#pragma unroll
      for (int i = 0; i < 16; ++i) mx = fmaxf(mx, s[kb][i]);
    mx = fmaxf(mx, __shfl_xor(mx, 32));
    float alpha = 1.f;
    if (!__all(mx - m <= 8.f)) {
      const float mn = fmaxf(m, mx);
      alpha = fexp2(m - mn);
      m = mn;
#pragma unroll
      for (int db = 0; db < 2; ++db)
#pragma unroll
        for (int i = 0; i < 16; ++i) o[db][i] *= alpha;
    }
    float ps = 0.f;
#pragma unroll
    for (int kb = 0; kb < 2; ++kb)
#pragma unroll
      for (int i = 0; i < 16; ++i) { s[kb][i] = fexp2(s[kb][i] - m); ps += s[kb][i]; }
    l = l * alpha + ps;
#pragma unroll
    for (int kb = 0; kb < 2; ++kb)
#pragma unroll
      for (int st = 0; st < 2; ++st) {
        const unsigned p0 = pk2(s[kb][8 * st + 0], s[kb][8 * st + 1]), p1 = pk2(s[kb][8 * st + 2], s[kb][8 * st + 3]);
        const unsigned p2 = pk2(s[kb][8 * st + 4], s[kb][8 * st + 5]), p3 = pk2(s[kb][8 * st + 6], s[kb][8 * st + 7]);
        const u32x4 pu = mk4(p0, p1, p2, p3);
        const bf16x8 pf = __builtin_bit_cast(bf16x8, pu);
#pragma unroll
        for (int db = 0; db < 2; ++db) {
          const s16x4 lo = *(const s16x4*)(Vs + (db * 32 + r) * 72 + kb * 32 + 16 * st + 4 * h);
          const s16x4 hi = *(const s16x4*)(Vs + (db * 32 + r) * 72 + kb * 32 + 16 * st + 8 + 4 * h);
          const bf16x8 vf = __builtin_shufflevector(lo, hi, 0, 1, 2, 3, 4, 5, 6, 7);
          o[db] = MFMA32(vf, pf, o[db]);
        }
      }
    }
  }
  l += __shfl_xor(l, 32);
  if (has_sink) {
    const float mn = fmaxf(m, sink2);
    const float alpha = fexp2(m - mn);
    l = l * alpha + fexp2(sink2 - mn);
#pragma unroll
    for (int db = 0; db < 2; ++db)
#pragma unroll
      for (int i = 0; i < 16; ++i) o[db][i] *= alpha;
  }
  const float inv = 1.f / l;
#pragma unroll
  for (int db = 0; db < 2; ++db)
#pragma unroll
    for (int ig = 0; ig < 4; ++ig) {
      const int dd = db * 32 + 8 * ig + 4 * h;
      const u32x2 gt = *(const u32x2*)(G + qrow * 1024 + head * 64 + dd);
      const float v0 = o[db][4 * ig] * inv * bf_lo(gt.x), v1 = o[db][4 * ig + 1] * inv * bf_hi(gt.x);
      const float v2 = o[db][4 * ig + 2] * inv * bf_lo(gt.y), v3 = o[db][4 * ig + 3] * inv * bf_hi(gt.y);
      *(u32x2*)(A2 + qrow * 1024 + head * 64 + dd) = mk2(pk2(v0, v1), pk2(v2, v3));
    }
}

DI int scan_tok(int s, int d) {
  if (s < 256) return 4096 + (d ? 255 - s : s);
  const int i = s - 256;
  return d ? 4095 - i : i;
}

template <class T> DI T ldgo(const void* base, unsigned byteoff) { return *(const T*)((const char*)base + byteoff); }
DI int scan_segoff(int sg, int d, int h) { return sg < 3 ? sg * 512 + h * 64 : 1536 + (sg - 3) * 128 + d * 64; }
DI float frcp(float x) { return __builtin_amdgcn_rcpf(x); }
DI float tanh_fast(float x) { const float e = __expf(2.f * x); return 1.f - 2.f * frcp(e + 1.f); }

#define GAS __attribute__((address_space(1)))
typedef GAS unsigned long long gu64;
typedef GAS unsigned gu32;
static constexpr int RING = 21;
static constexpr int SLOT_F = 3200;
DI int rec_voff(int vec) { return vec * 64 + (vec >= 3 ? 64 : 0); }
static constexpr size_t OFF_RING = OFF_Q + 17825792;
DI unsigned flag_ld(unsigned* f) { return __hip_atomic_load(f, __ATOMIC_RELAXED, __HIP_MEMORY_SCOPE_AGENT); }
DI void flag_st(unsigned* f, unsigned v) { __hip_atomic_store(f, v, __ATOMIC_RELAXED, __HIP_MEMORY_SCOPE_AGENT); }
#define FLAG_PROD(chain, par) ((unsigned*)(p.ws + OFF_FLAGS) + ((chain) * 2 + (par)) * 64)
#define FLAG_CONS(chain, sp) ((unsigned*)(p.ws + OFF_FLAGS) + (128 + (chain) * 4 + (sp)) * 64)
#define FLAG_TMO ((unsigned*)(p.ws + OFF_FLAGS) + 384 * 64)
#define PC_WAIT(cond) do { unsigned _sp = 0; while (cond) { __builtin_amdgcn_s_sleep(1); \
    if ((++_sp & 1023u) == 0u) { if (flag_ld(FLAG_TMO)) break; if (_sp > (1u << 22)) { flag_st(FLAG_TMO, 1u); break; } } } } while (0)

#ifndef NPROD
#define NPROD 2
#endif
DI void scan_producer(const Params& p, char* smem, int chain, int par) {
  __builtin_amdgcn_s_setprio(2);
  const int tid = threadIdx.x, lane = tid & 63, w = tid >> 6;
  const int d = chain >> 5, b = (chain >> 3) & 3, h = chain & 7;
  float* REC = (float*)smem;
  float* RSs = REC + 8 * 768;
  float* KSs = RSs + 1024;
  float* INVN = KSs + 1024;
  float* SCP = INVN + 16;
  float* BONP = SCP + 128;
  float* CST = BONP + 64;
  u16* ZW = (u16*)(CST + 768);
  u16* ZA = ZW + 16 * 72;
  u16* RAW = ZA + 16 * 72;
  const u16* PB = (const u16*)(p.ws + OFF_PB);
  u16* VSH = (u16*)(p.ws + OFF_VSH);
  float* BONS = (float*)(p.ws + OFF_BONS);
  float* ring = (float*)(p.ws + OFF_RING) + (size_t)chain * RING * SLOT_F;

  if (tid < 64) {
    const unsigned hc = (unsigned)(h * 64 + tid) * 4u, dhc = (unsigned)(d * 512 + h * 64 + tid) * 4u;
#pragma unroll
    for (int sg = 0; sg < 5; ++sg) CST[sg * 64 + tid] = ldgo<float>(p.mu_b, (unsigned)(scan_segoff(sg, d, h) + tid) * 4u);
    CST[320 + tid] = ldgo<float>(p.kk_b, hc);
    CST[512 + tid] = ldgo<float>(p.w0_b, dhc);
    CST[576 + tid] = ldgo<float>(p.a0_b, dhc);
    CST[640 + tid] = ldgo<float>(p.ka_b, hc);
    CST[704 + tid] = ldgo<float>(p.rk_b, hc);
  }
  const int t1 = tid >> 4, q = tid & 15, c4 = q * 4;
  const int hhi = tid / 80, hsg = (tid % 80) >> 4;
  const int c2 = 16 * w + (lane & 15), tg = lane >> 4;
  bf16x8 bw[2], ba[2];
#pragma unroll
  for (int ks = 0; ks < 2; ++ks) {
    unsigned uw[4], ua[4];
#pragma unroll
    for (int e2 = 0; e2 < 4; ++e2) {
      const int j0 = tg * 8 + 32 * ks + 2 * e2;
      const unsigned o0 = (unsigned)((d * 64 + j0) * 512 + h * 64 + c2) * 4u;
      uw[e2] = pk2(ldgo<float>(p.w2_b, o0), ldgo<float>(p.w2_b, o0 + 2048u));
      ua[e2] = pk2(ldgo<float>(p.a2_b, o0), ldgo<float>(p.a2_b, o0 + 2048u));
    }
    bw[ks] = __builtin_bit_cast(bf16x8, mk4(uw[0], uw[1], uw[2], uw[3]));
    ba[ks] = __builtin_bit_cast(bf16x8, mk4(ua[0], ua[1], ua[2], ua[3]));
  }
  u32x2 pr[5], ph = mk2(0u, 0u);
  const unsigned pbase = (unsigned)(b * TT) * 3584u;
#define SCAN_LOAD(CH)                                                                                                   \
  {                                                                                                                     \
    const unsigned ro_ = pbase + (unsigned)scan_tok((CH) * 16 + t1, d) * 3584u + (unsigned)c4 * 2u;                     \
    _Pragma("unroll") for (int sg = 0; sg < 5; ++sg) pr[sg] = ldgo<u32x2>(PB, ro_ + (unsigned)scan_segoff(sg, d, h) * 2u); \
    if (tid < 160) {                                                                                                    \
      const int sh_ = hhi ? (CH) * 16 + 16 : (CH) * 16 - 1;                                                             \
      const bool valid_ = hhi ? (sh_ != 256 && sh_ != 4352) : (sh_ != -1 && sh_ != 255);                               \
      ph = mk2(0u, 0u);                                                                                                 \
      if (valid_) ph = ldgo<u32x2>(PB, pbase + (unsigned)scan_tok(sh_, d) * 3584u + (unsigned)(scan_segoff(hsg, d, h) + c4) * 2u); \
    }                                                                                                                   \
  }
  SCAN_LOAD(par)
  int pub = -1;
  for (int ch = par; ch < 272; ch += NPROD) {
#pragma unroll
    for (int sg = 0; sg < 5; ++sg) *(u32x2*)(RAW + (t1 + 1) * 320 + sg * 64 + c4) = pr[sg];
    if (tid < 160) *(u32x2*)(RAW + (hhi * 17) * 320 + hsg * 64 + c4) = ph;
    asm volatile("s_waitcnt vmcnt(0)" ::: "memory");
    __syncthreads();
    if (tid == 0 && pub >= 0) flag_st(FLAG_PROD(chain, par), (unsigned)(pub + 1));
    unsigned cseen = 0xffffffffu;
    if (ch >= RING && tid < 4) cseen = flag_ld(FLAG_CONS(chain, tid));
    const int tok = scan_tok(ch * 16 + t1, d);
    {
      float sv[5][4];
#pragma unroll
      for (int sg = 0; sg < 5; ++sg) {
        const u32x2 cu = *(const u32x2*)(RAW + (t1 + 1) * 320 + sg * 64 + c4);
        const u32x2 pu = *(const u32x2*)(RAW + t1 * 320 + sg * 64 + c4);
        const u32x2 nu = *(const u32x2*)(RAW + (t1 + 2) * 320 + sg * 64 + c4);
        const f32x4 mu = *(const f32x4*)(CST + sg * 64 + c4);
        const float c0 = bf_lo(cu.x), c1 = bf_hi(cu.x), c2v = bf_lo(cu.y), c3 = bf_hi(cu.y);
        const float n0 = 0.5f * (bf_lo(pu.x) + bf_lo(nu.x)), n1 = 0.5f * (bf_hi(pu.x) + bf_hi(nu.x));
        const float n2 = 0.5f * (bf_lo(pu.y) + bf_lo(nu.y)), n3 = 0.5f * (bf_hi(pu.y) + bf_hi(nu.y));
        sv[sg][0] = c0 + mu[0] * (n0 - c0); sv[sg][1] = c1 + mu[1] * (n1 - c1);
        sv[sg][2] = c2v + mu[2] * (n2 - c2v); sv[sg][3] = c3 + mu[3] * (n3 - c3);
      }
      *(f32x4*)(RSs + t1 * 64 + c4) = (f32x4){sv[0][0], sv[0][1], sv[0][2], sv[0][3]};
      *(f32x4*)(KSs + t1 * 64 + c4) = (f32x4){sv[1][0], sv[1][1], sv[1][2], sv[1][3]};
      {
        float* vp = REC + (t1 >> 1) * 768 + 576 + c4 * 2 + (t1 & 1);
        vp[0] = sv[2][0]; vp[2] = sv[2][1]; vp[4] = sv[2][2]; vp[6] = sv[2][3];
      }
      if (d == 0) *(u32x2*)(VSH + (size_t)(b * TT + tok) * 512 + h * 64 + c4) = mk2(pk2(sv[2][0], sv[2][1]), pk2(sv[2][2], sv[2][3]));
      *(u32x2*)(ZW + t1 * 72 + c4) = mk2(pk2(tanh_fast(sv[3][0]), tanh_fast(sv[3][1])), pk2(tanh_fast(sv[3][2]), tanh_fast(sv[3][3])));
      *(u32x2*)(ZA + t1 * 72 + c4) = mk2(pk2(sv[4][0], sv[4][1]), pk2(sv[4][2], sv[4][3]));
      const f32x4 kkc1 = *(const f32x4*)(CST + 320 + c4);
      float ssq = 0.f;
#pragma unroll
      for (int e = 0; e < 4; ++e) { const float kq = sv[1][e] * kkc1[e]; ssq += kq * kq; }
      ssq = reduce16(ssq);
      if (q == 0) INVN[t1] = frcp(fmaxf(sqrtf(ssq), 1e-12f));
    }
    if (ch + NPROD < 272) SCAN_LOAD(ch + NPROD)
    __syncthreads();
    {
      const bf16x8 az0 = *(const bf16x8*)(ZW + (lane & 15) * 72 + tg * 8), az1 = *(const bf16x8*)(ZW + (lane & 15) * 72 + tg * 8 + 32);
      const bf16x8 aa0 = *(const bf16x8*)(ZA + (lane & 15) * 72 + tg * 8), aa1 = *(const bf16x8*)(ZA + (lane & 15) * 72 + tg * 8 + 32);
      f32x4 xw = {0.f, 0.f, 0.f, 0.f}, xa = {0.f, 0.f, 0.f, 0.f};
      xw = MFMA16(az0, bw[0], xw); xw = MFMA16(az1, bw[1], xw);
      xa = MFMA16(aa0, ba[0], xa); xa = MFMA16(aa1, ba[1], xa);
      const float w0c = CST[512 + c2], a0c = CST[576 + c2], kkc2 = CST[320 + c2], kac = CST[640 + c2], rkc = CST[704 + c2];
      float wv[4], kkv[4], bvv[4], kmv[4], rv4[4];
#pragma unroll
      for (int i = 0; i < 4; ++i) {
        const int t = tg * 4 + i;
        const float sgw = frcp(1.f + __expf(-(w0c + xw[i])));
        wv[i] = __expf(-0.6065306597126334f * sgw);
        const float a = frcp(1.f + __expf(-(a0c + xa[i])));
        const float k = KSs[t * 64 + c2];
        rv4[i] = RSs[t * 64 + c2];
        kkv[i] = k * kkc2 * INVN[t];
        bvv[i] = kkv[i] * a;
        kmv[i] = k * (1.f + (a - 1.f) * kac);
        const float bop = reduce16(rv4[i] * kmv[i] * rkc);
        if ((lane & 15) == 0) BONP[t * 4 + w] = bop;
      }
#pragma unroll
      for (int j = 0; j < 2; ++j) {
        const int ia = 2 * j, ib = 2 * j + 1, pp = 2 * tg + j;
        float* R = REC + pp * 768;
        R[c2] = kkv[ia]; R[64 + c2] = wv[ia] * kkv[ib]; R[128 + c2] = wv[ia] * rv4[ia]; R[192 + c2] = wv[ia] * wv[ib];
        R[256 + c2] = bvv[ia] * wv[ib]; R[320 + c2] = kmv[ia] * wv[ib]; R[384 + c2] = bvv[ib]; R[448 + c2] = kmv[ib]; R[512 + c2] = rv4[ib];
        const float s1 = reduce16(bvv[ia] * kkv[ib]), s2 = reduce16(kmv[ia] * kkv[ib]);
        const float s3 = reduce16(bvv[ia] * rv4[ia]), s4 = reduce16(kmv[ia] * rv4[ia]);
        if ((lane & 15) == 0) { SCP[(pp * 4 + 0) * 4 + w] = s1; SCP[(pp * 4 + 1) * 4 + w] = s2; SCP[(pp * 4 + 2) * 4 + w] = s3; SCP[(pp * 4 + 3) * 4 + w] = s4; }
      }
    }
    __syncthreads();
    if (ch >= RING && tid < 4 && cseen < (unsigned)(ch - RING + 1)) PC_WAIT(flag_ld(FLAG_CONS(chain, tid)) < (unsigned)(ch - RING + 1));
    if (tid < 32) {
      const f32x4 v = *(const f32x4*)(SCP + tid * 4);
      REC[(tid >> 2) * 768 + 704 + (tid & 3)] = (v[0] + v[1]) + (v[2] + v[3]);
    } else if (tid < 48) {
      const int tt = tid - 32;
      const f32x4 v = *(const f32x4*)(BONP + tt * 4);
      BONS[(size_t)(d * MROWS + b * TT + scan_tok(ch * 16 + tt, d)) * 8 + h] = (v[0] + v[1]) + (v[2] + v[3]);
    }
    __syncthreads();
    {
      gu64* dst = (gu64*)(ring + (size_t)(ch % RING) * SLOT_F);
      {
        const int pp = tid >> 5, k = tid & 31;
        const f32x2 wv2 = *(const f32x2*)(REC + pp * 768 + 192 + 2 * k);
        __hip_atomic_store(dst + tid, (unsigned long long)__float_as_uint(wv2[0]) | ((unsigned long long)__float_as_uint(wv2[1]) << 32), __ATOMIC_RELAXED, __HIP_MEMORY_SCOPE_AGENT);
      }
#pragma unroll
      for (int n = 0; n < 4; ++n) {
        const int idx = n * 256 + tid, pp = idx >> 7, vec = (idx >> 4) & 7, k = idx & 15;
        const f32x4 v = *(const f32x4*)(REC + pp * 768 + rec_voff(vec) + 4 * k);
        __hip_atomic_store(dst + 256 + idx, (unsigned long long)pk2(v[0], v[1]) | ((unsigned long long)pk2(v[2], v[3]) << 32), __ATOMIC_RELAXED, __HIP_MEMORY_SCOPE_AGENT);
      }
      {
        const int pp = tid >> 5, k = tid & 31;
        const f32x4 v = *(const f32x4*)(REC + pp * 768 + 576 + 4 * k);
        __hip_atomic_store(dst + 1280 + tid, (unsigned long long)pk2(v[0], v[1]) | ((unsigned long long)pk2(v[2], v[3]) << 32), __ATOMIC_RELAXED, __HIP_MEMORY_SCOPE_AGENT);
      }
      if (tid < 16) {
        const f32x2 sv2 = *(const f32x2*)(REC + (tid >> 1) * 768 + 704 + 2 * (tid & 1));
        __hip_atomic_store(dst + 1536 + tid, (unsigned long long)__float_as_uint(sv2[0]) | ((unsigned long long)__float_as_uint(sv2[1]) << 32), __ATOMIC_RELAXED, __HIP_MEMORY_SCOPE_AGENT);
      }
    }
    pub = ch;
  }
  asm volatile("s_waitcnt vmcnt(0)" ::: "memory");
  __syncthreads();
  if (tid == 0 && pub >= 0) flag_st(FLAG_PROD(chain, par), (unsigned)(pub + 1));
  __builtin_amdgcn_s_setprio(0);
#undef SCAN_LOAD
}

DI void red16x2(float& x, float& y) {
  asm("s_nop 1\n\tv_add_f32_dpp %0, %0, %0 quad_perm:[1,0,3,2] row_mask:0xf bank_mask:0xf\n\tv_add_f32_dpp %1, %1, %1 quad_perm:[1,0,3,2] row_mask:0xf bank_mask:0xf\n\ts_nop 0\n\t"
      "v_add_f32_dpp %0, %0, %0 quad_perm:[2,3,0,1] row_mask:0xf bank_mask:0xf\n\tv_add_f32_dpp %1, %1, %1 quad_perm:[2,3,0,1] row_mask:0xf bank_mask:0xf\n\ts_nop 0\n\t"
      "v_add_f32_dpp %0, %0, %0 row_ror:4 row_mask:0xf bank_mask:0xf\n\tv_add_f32_dpp %1, %1, %1 row_ror:4 row_mask:0xf bank_mask:0xf\n\ts_nop 0\n\t"
      "v_add_f32_dpp %0, %0, %0 row_ror:8 row_mask:0xf bank_mask:0xf\n\tv_add_f32_dpp %1, %1, %1 row_ror:8 row_mask:0xf bank_mask:0xf"
      : "+v"(x), "+v"(y));
}
DI void scan_consumer(const Params& p, char* smem, int chain, int split) {
  constexpr int RPB = 16, RPW = 4, LPR = 16, YPT = RPB * LPR;
  __builtin_amdgcn_s_setprio(3);
  const int tid = threadIdx.x, lane = tid & 63, w = tid >> 6;
  const int d = chain >> 5, b = (chain >> 3) & 3, h = chain & 7;
  float* REC = (float*)smem;
  float* YB = REC + 8 * 768;
  u16* YR = (u16*)(p.ws + OFF_OB);
  const float* ring = (const float*)(p.ws + OFF_RING) + (size_t)chain * RING * SLOT_F;
  const int t1 = tid >> 4, q = tid & 15;
  const int g = lane & (LPR - 1), rowb0 = w * RPW + (lane / LPR);
  f32x2 S0 = {0.f, 0.f}, S1 = {0.f, 0.f};
  unsigned long long nxA[7], nxB[7];
#define CONS_ISSUE(NX, CH)                                                                                              \
  {                                                                                                                     \
    const gu64* src_ = (const gu64*)(ring + (size_t)((CH) % RING) * SLOT_F);                                            \
    _Pragma("unroll") for (int j = 0; j < 6; ++j) NX[j] = __hip_atomic_load(src_ + j * 256 + tid, __ATOMIC_RELAXED, __HIP_MEMORY_SCOPE_AGENT); \
    NX[6] = 0ull;                                                                                                       \
    if (tid < 16) NX[6] = __hip_atomic_load(src_ + 1536 + tid, __ATOMIC_RELAXED, __HIP_MEMORY_SCOPE_AGENT);             \
  }
#define CONS_INSTALL(NX)                                                                                                \
  {                                                                                                                     \
    {                                                                                                                   \
      const int pp_ = tid >> 5, k_ = tid & 31;                                                                          \
      *(f32x2*)(REC + pp_ * 768 + 192 + 2 * k_) = (f32x2){__uint_as_float((unsigned)NX[0]), __uint_as_float((unsigned)(NX[0] >> 32))}; \
      const unsigned lo_ = (unsigned)NX[5], hi_ = (unsigned)(NX[5] >> 32);                                              \
      *(f32x4*)(REC + pp_ * 768 + 576 + 4 * k_) = (f32x4){bf_lo(lo_), bf_hi(lo_), bf_lo(hi_), bf_hi(hi_)};              \
    }                                                                                                                   \
    _Pragma("unroll") for (int n = 0; n < 4; ++n) {                                                                     \
      const int idx_ = n * 256 + tid, pp_ = idx_ >> 7, vec_ = (idx_ >> 4) & 7, k_ = idx_ & 15;                          \
      const unsigned lo_ = (unsigned)NX[1 + n], hi_ = (unsigned)(NX[1 + n] >> 32);                                      \
      *(f32x4*)(REC + pp_ * 768 + rec_voff(vec_) + 4 * k_) = (f32x4){bf_lo(lo_), bf_hi(lo_), bf_lo(hi_), bf_hi(hi_)};   \
    }                                                                                                                   \
    if (tid < 16) *(f32x2*)(REC + (tid >> 1) * 768 + 704 + 2 * (tid & 1)) = (f32x2){__uint_as_float((unsigned)NX[6]), __uint_as_float((unsigned)(NX[6] >> 32))}; \
  }
  if (tid == 0) PC_WAIT(flag_ld(FLAG_PROD(chain, 0)) < 1u);
  __syncthreads();
  CONS_ISSUE(nxA, 0)
  CONS_INSTALL(nxA)
  if (tid == 0) PC_WAIT(flag_ld(FLAG_PROD(chain, 1 % NPROD)) < 2u);
  __syncthreads();
  CONS_ISSUE(nxA, 1)
  unsigned fnext = 0u;
  if (tid == 0) fnext = flag_ld(FLAG_PROD(chain, 2 % NPROD));
#define CONS_FETCH(PP, BUF)                                                                                             \
  {                                                                                                                     \
    const float* Rb_ = REC + (PP) * 768;                                                                                \
    _Pragma("unroll") for (int f = 0; f < 9; ++f) L[BUF][f] = *(const f32x4*)(Rb_ + f * 64 + 4 * g);                    \
    vv[BUF] = *(const f32x2*)(Rb_ + 576 + (split * RPB + rowb0) * 2);                                                   \
    sc[BUF] = *(const f32x4*)(Rb_ + 704);                                                                               \
  }
#define CONS_ITER(CH, NXC, NXN)                                                                                         \
  {                                                                                                                     \
    const int ch = (CH);                                                                                                \
      \
    if (tid == 0 && ch + 3 < 272) fnext = flag_ld(FLAG_PROD(chain, (ch + 3) % NPROD));                                  \
    if (ch + 2 < 272) CONS_ISSUE(NXN, ch + 2)    \
    {                                                                                                                   \
      f32x4 L[2][9]; f32x2 vv[2]; f32x4 sc[2];                                                                          \
      CONS_FETCH(0, 0)                                                                                                  \
      _Pragma("unroll") for (int pp = 0; pp < 8; ++pp) {                                                                \
        const int cbf = pp & 1;                                                                                         \
        if (pp < 7) CONS_FETCH(pp + 1, cbf ^ 1)                                                                         \
        const f32x4 KA = L[cbf][0], P1 = L[cbf][1], P2 = L[cbf][2], W2 = L[cbf][3], B1 = L[cbf][4], K1 = L[cbf][5];     \
        const f32x4 BB = L[cbf][6], KBv = L[cbf][7], RB = L[cbf][8];                                                    \
        const float va = vv[cbf][0], vb = vv[cbf][1];                                                                   \
        f32x2 e1 = S0 * KA.xy; e1 += S1 * KA.zw;                                                                        \
        f32x2 e2 = S0 * P1.xy; e2 += S1 * P1.zw;                                                                        \
        f32x2 e3 = S0 * P2.xy; e3 += S1 * P2.zw;                                                                        \
        float sa_a = e1[0] + e1[1], raw2 = e2[0] + e2[1];                                                               \
        const float d3 = e3[0] + e3[1];                                                                                 \
        red16x2(sa_a, raw2);                                                                                            \
        const f32x2 va2 = {va, va}, vb2 = {vb, vb}, saa2 = {sa_a, sa_a};                                                \
        f32x2 pre0 = S0 * W2.xy + (va2 * K1.xy - saa2 * B1.xy) + vb2 * KBv.xy;                                          \
        f32x2 pre1 = S1 * W2.zw + (va2 * K1.zw - saa2 * B1.zw) + vb2 * KBv.zw;                                          \
        const float sa_b = raw2 - sa_a * sc[cbf][0] + va * sc[cbf][1];                                                  \
        const f32x2 sab2 = {sa_b, sa_b};                                                                                \
        S0 = pre0 - sab2 * BB.xy;                                                                                       \
        S1 = pre1 - sab2 * BB.zw;                                                                                       \
        const float fix = (g == 0) ? (va * sc[cbf][3] - sa_a * sc[cbf][2]) : 0.f;                                       \
        f32x2 yb2 = S0 * RB.xy; yb2 += S1 * RB.zw;                                                                      \
        YB[(2 * pp) * YPT + rowb0 * LPR + g] = d3 + fix;                                                                \
        YB[(2 * pp + 1) * YPT + rowb0 * LPR + g] = yb2[0] + yb2[1];                                                     \
      }                                                                                                                 \
    }                                                                                                                   \
    __syncthreads();                                                                                                    \
    {                                                                                                                   \
      const float* yp = YB + t1 * YPT + q * LPR;                                                                        \
      float a = 0.f;                                                                                                    \
      _Pragma("unroll") for (int k4 = 0; k4 < LPR / 4; ++k4) { const f32x4 v = *(const f32x4*)(yp + 4 * k4); a += (v[0] + v[1]) + (v[2] + v[3]); } \
      const unsigned orow = (unsigned)(d * MROWS + b * TT + scan_tok(ch * 16 + t1, d));                                 \
      YR[(size_t)orow * 512 + h * 64 + split * RPB + q] = bf1(a);                                                       \
    }                                                                                                                   \
    if (ch + 1 < 272) CONS_INSTALL(NXC)                                                                                 \
    if (tid == 0 && ch + 3 < 272 && fnext < (unsigned)(ch + 4)) PC_WAIT(flag_ld(FLAG_PROD(chain, (ch + 3) % NPROD)) < (unsigned)(ch + 4)); \
    __syncthreads();                                                                                                    \
    if (ch + 1 < 272 && tid == 0) flag_st(FLAG_CONS(chain, split), (unsigned)(ch + 2));     \
  }
  if (tid == 0 && fnext < 3u) PC_WAIT(flag_ld(FLAG_PROD(chain, 2 % NPROD)) < 3u);
  __syncthreads();
  for (int c2i = 0; c2i < 272; c2i += 2) {
    CONS_ITER(c2i, nxA, nxB)
    CONS_ITER(c2i + 1, nxB, nxA)
  }
#undef CONS_ISSUE
#undef CONS_INSTALL
#undef CONS_FETCH
#undef CONS_ITER
  __builtin_amdgcn_s_setprio(0);
}

DI void phase_mixer0(const Params& p, char* smem, int vb, int nvb) {
  constexpr int NROLE = 256 + 64 * NPROD;
  __shared__ int s_item;
  if (vb < 256) scan_consumer(p, smem, vb & 63, vb >> 6);
  else if (vb < NROLE) scan_producer(p, smem, (vb - 256) & 63, (vb - 256) >> 6);
  unsigned* ctr = (unsigned*)(p.ws + OFF_FLAGS) + 385 * 64;
  for (;;) {
    __syncthreads();
    if (threadIdx.x == 0) s_item = (int)__hip_atomic_fetch_add(ctr, 1u, __ATOMIC_RELAXED, __HIP_MEMORY_SCOPE_AGENT);
    __syncthreads();
    const int it = s_item;
    if (it >= 1088) break;
    if (it < 1024) {
      const int b = it >> 8, head = (it >> 5) & 7, qb = it & 31;
      attn_block(p, smem, 512, 2, b, head, qb * 128, 0, 68, 0, 0, false, false, 0.f);
    } else {
      const int j = it - 1024;
      const int b = j >> 4, head = (j >> 1) & 7, qb = j & 1;
      attn_block(p, smem, 512, 2, b, head, 4096 + qb * 128, 64, 4, 0, 0, false, false, 0.f);
    }
  }
}

DI void phase_combine(const Params& p, int vb, int nvb) {
  const u16* YR = (const u16*)(p.ws + OFF_OB);
  const u16* VSH = (const u16*)(p.ws + OFF_VSH);
  const float* BONS = (const float*)(p.ws + OFF_BONS);
  const u16* G = (const u16*)(p.ws + OFF_G);
  u16* A2 = (u16*)(p.ws + OFF_HX);
  const int q = threadIdx.x & 15, pi = threadIdx.x >> 4;
  for (int u = vb; u < MROWS * 8 / 16; u += nvb) {
    const int pair = u * 16 + pi;
    const size_t row = (size_t)(pair >> 3); const int h = pair & 7;
    const int col = h * 64 + 4 * q;
    const f32x4 gnw = *(const f32x4*)(p.gn_w_b + col), gnb = *(const f32x4*)(p.gn_b_b + col);
    const u32x2 vu = *(const u32x2*)(VSH + row * 512 + col);
    const float v0 = bf_lo(vu.x), v1 = bf_hi(vu.x), v2 = bf_lo(vu.y), v3 = bf_hi(vu.y);
    float a0 = 0.f, a1 = 0.f, a2 = 0.f, a3 = 0.f;
#pragma unroll
    for (int d = 0; d < 2; ++d) {
      const u32x2 yu = *(const u32x2*)(YR + ((size_t)d * MROWS + row) * 512 + col);
      const float y0 = bf_lo(yu.x), y1 = bf_hi(yu.x), y2 = bf_lo(yu.y), y3 = bf_hi(yu.y);
      const float mean = reduce16((y0 + y1) + (y2 + y3)) * (1.f / 64.f);
      const float d0 = y0 - mean, d1 = y1 - mean, d2 = y2 - mean, d3 = y3 - mean;
      const float var = reduce16(d0 * d0 + d1 * d1 + d2 * d2 + d3 * d3) * (1.f / 64.f);
      const float rstd = rsqrtf(var + 64e-5f);
      const float bon = BONS[((size_t)d * MROWS + row) * 8 + h];
      a0 += d0 * rstd * gnw[0] + gnb[0] + bon * v0; a1 += d1 * rstd * gnw[1] + gnb[1] + bon * v1;
      a2 += d2 * rstd * gnw[2] + gnb[2] + bon * v2; a3 += d3 * rstd * gnw[3] + gnb[3] + bon * v3;
    }
    const u32x2 gq = *(const u32x2*)(G + row * 1024 + 512 + col);
    *(u32x2*)(A2 + row * 1024 + 512 + col) = mk2(pk2(a0 * bf_lo(gq.x), a1 * bf_hi(gq.x)), pk2(a2 * bf_lo(gq.y), a3 * bf_hi(gq.y)));
  }
}

DI void phase_post(const Params& p, int vb, int nvb) {
  const int tid = threadIdx.x, lane = tid & 63, w = tid >> 6;
  const float* MOD = (const float*)(p.ws + OFF_MOD);
  const u16* Y = (const u16*)(p.ws + OFF_Y);
  u16* HX = (u16*)(p.ws + OFF_HX);
  for (int u = vb; u < MROWS / 4; u += nvb) {
    const int rowg = u * 4 + w;
    const int b = rowg / TT, tok = rowg - b * TT;
    const bool lat = tok < 4096;
    const float* src = lat ? p.x + ((size_t)b * 4096 + tok) * 1024 : p.ctx + ((size_t)b * 256 + (tok - 4096)) * 1024;
    const float* mod0 = MOD + (0 * 5 + (lat ? b : 4)) * 3072;
    const float* mod1 = MOD + (1 * 5 + (lat ? b : 4)) * 3072;
    f32x4 yv[4]; float ss = 0.f;
#pragma unroll
    for (int j = 0; j < 4; ++j) { const u32x2 yu = *(const u32x2*)(Y + (size_t)rowg * 1024 + j * 256 + lane * 4); yv[j] = (f32x4){bf_lo(yu.x), bf_hi(yu.x), bf_lo(yu.y), bf_hi(yu.y)}; ss += yv[j][0] * yv[j][0] + yv[j][1] * yv[j][1] + yv[j][2] * yv[j][2] + yv[j][3] * yv[j][3]; }
    ss = wave_sum(ss);
    const float rinv = rsqrtf(ss * (1.f / 1024.f) + 1e-6f);
    f32x4 x1[4]; float s1 = 0.f;
#pragma unroll
    for (int j = 0; j < 4; ++j) {
      const int col = j * 256 + lane * 4;
      const f32x4 xv = __builtin_nontemporal_load((const f32x4*)(src + col)), gp = *(const f32x4*)(p.g_post + col), gt = *(const f32x4*)(mod0 + 2048 + col);
#pragma unroll
      for (int e = 0; e < 4; ++e) { x1[j][e] = xv[e] + gt[e] * (yv[j][e] * rinv * gp[e]); s1 += x1[j][e] * x1[j][e]; }
      if (lat) *(u32x2*)((u16*)(p.ws + OFF_OB) + ((size_t)b * 4096 + tok) * 1024 + col) = mk2(pk2(x1[j][0], x1[j][1]), pk2(x1[j][2], x1[j][3]));
    }
    s1 = wave_sum(s1);
    const float rinv1 = rsqrtf(s1 * (1.f / 1024.f) + 1e-6f);
#pragma unroll
    for (int j = 0; j < 4; ++j) {
      const int col = j * 256 + lane * 4;
      const f32x4 g = *(const f32x4*)(p.g_pre + 1024 + col), sh = *(const f32x4*)(mod1 + col), scv = *(const f32x4*)(mod1 + 1024 + col);
      float hv[4];
#pragma unroll
      for (int e = 0; e < 4; ++e) hv[e] = (x1[j][e] * rinv1 * g[e]) * (1.f + scv[e]) + sh[e];
      *(u32x2*)(HX + (size_t)rowg * 1024 + col) = mk2(pk2(hv[0], hv[1]), pk2(hv[2], hv[3]));
    }
  }
}

DI void phase_attn1(const Params& p, char* smem, int vb, int nvb) {
  for (int it = vb; it < 2048; it += nvb) {
    const int b = it >> 9, head = (it >> 5) & 15, qb = it & 31;
    const int q0 = qb * 128;
    const int lo = (q0 - 128 < 0) ? 0 : q0 - 128, hi = (q0 + 256 > 4096) ? 4096 : q0 + 256;
    attn_block(p, smem, 1024, 4, b, head, q0, 64, 4, lo >> 6, (hi - lo) >> 6, true, true, p.sink_c[head] * 1.4426950408889634f);
  }
}

DI void phase_final(const Params& p, int vb, int nvb) {
  const int tid = threadIdx.x, lane = tid & 63, w = tid >> 6;
  const float* MOD = (const float*)(p.ws + OFF_MOD);
  const u16* Y = (const u16*)(p.ws + OFF_Y);
  for (int u = vb; u < 4096; u += nvb) {
    const int rowl = u * 4 + w;
    const int b = rowl >> 12, tok = rowl & 4095;
    const size_t rowg = (size_t)b * TT + tok;
    const float* mod1 = MOD + (1 * 5 + b) * 3072;
    f32x4 yv[4]; float ss = 0.f;
#pragma unroll
    for (int j = 0; j < 4; ++j) { const u32x2 yu = *(const u32x2*)(Y + rowg * 1024 + j * 256 + lane * 4); yv[j] = (f32x4){bf_lo(yu.x), bf_hi(yu.x), bf_lo(yu.y), bf_hi(yu.y)}; ss += yv[j][0] * yv[j][0] + yv[j][1] * yv[j][1] + yv[j][2] * yv[j][2] + yv[j][3] * yv[j][3]; }
    ss = wave_sum(ss);
    const float rinv = rsqrtf(ss * (1.f / 1024.f) + 1e-6f);
#pragma unroll
    for (int j = 0; j < 4; ++j) {
      const int col = j * 256 + lane * 4;
      float* op = p.out + (size_t)rowl * 1024 + col;
      const u32x2 xu = *(const u32x2*)((const u16*)(p.ws + OFF_OB) + (size_t)rowl * 1024 + col);
      const f32x4 xv = {bf_lo(xu.x), bf_hi(xu.x), bf_lo(xu.y), bf_hi(xu.y)}, gp = *(const f32x4*)(p.g_post + 1024 + col), gt = *(const f32x4*)(mod1 + 2048 + col);
      f32x4 ov;
#pragma unroll
      for (int e = 0; e < 4; ++e) ov[e] = xv[e] + gt[e] * (yv[j][e] * rinv * gp[e]);
      __builtin_nontemporal_store(ov, (f32x4*)op);
    }
  }
}

#ifndef PHMASK
#define PHMASK 0x7ff
#endif
#ifndef LB2
#define LB2 2
#endif
#define PH_ON(i) (((PHMASK) >> (i)) & 1)
static constexpr int SMEM_BYTES = 73728;
__global__ void __launch_bounds__(256, LB2) hybrid_fwd(Params p) {
  extern __shared__ __attribute__((aligned(16))) char smem[];
  __shared__ u32x4 xb_words;
  cg::grid_group grid = cg::this_grid();
  const int vb = blockIdx.x, nvb = gridDim.x;
  XcdBarrier xb; xb.bar = (unsigned*)(p.ws + OFF_BAR); xb.x = 0; xb.st = (volatile LAS unsigned*)&xb_words;
  if (p.ph_hi - p.ph_lo > 1) {
    if (threadIdx.x == 0) xb_words = (u32x4){0u, 0u, 0u, 0u};
    __syncthreads();
    xb = xcd_barrier_post((unsigned*)(p.ws + OFF_BAR), (volatile LAS unsigned*)&xb_words);
  }
#ifndef DUP_PH
#define DUP_PH -1
#endif
#define RUN_PH(i, call)                                            \
  if (PH_ON(i) && p.ph_lo <= (i) && (i) < p.ph_hi) { call; if ((i) == DUP_PH) { __syncthreads(); call; } }         \
  if (p.ph_lo <= (i) && (i) + 1 < p.ph_hi) { if (p.ph_hi > 1000) grid.sync(); else xcd_barrier(xb); }
#ifdef EXTRA_SYNC
  for (int es = 0; es < EXTRA_SYNC; ++es) grid.sync();
#endif
  RUN_PH(0, phase_prep(p, smem, vb, nvb))
  int vid = vb;
  if (p.ph_hi - p.ph_lo > 1) {
    if (threadIdx.x == 0) {
      unsigned base = 0u;
#pragma unroll
      for (unsigned j = 0; j < 16; ++j) { const unsigned c = xb_ld(&xb.bar[XB_XCNT(j)]); base += (j < xb.x) ? c : 0u; }
      xb.st[3] = base + xb.st[2];
    }
    __syncthreads();
    vid = (int)xb.st[3];
  }
  RUN_PH(1, phase_prenorm0(p, vb, nvb))
  RUN_PH(2, gemm_phase<0>(p, smem, vb, nvb, (const u16*)(p.ws + OFF_WT0), (const u16*)(p.ws + OFF_HX), 28))
  RUN_PH(3, phase_mixer0(p, smem, vb, nvb))
  RUN_PH(4, phase_combine(p, vb, nvb))
  RUN_PH(5, gemm_phase<1>(p, smem, vb, nvb, (const u16*)(p.ws + OFF_WT1), (const u16*)(p.ws + OFF_HX), 8))
  RUN_PH(6, phase_post(p, vb, nvb))
  RUN_PH(7, gemm_phase<2>(p, smem, vb, nvb, (const u16*)(p.ws + OFF_WT2), (const u16*)(p.ws + OFF_HX), 20))
  RUN_PH(8, phase_attn1(p, smem, vb, nvb))
  RUN_PH(9, gemm_phase<3>(p, smem, vb, nvb, (const u16*)(p.ws + OFF_WT3), (const u16*)(p.ws + OFF_HX), 8))
  RUN_PH(10, phase_final(p, vb, nvb))
#undef RUN_PH
}

extern "C" void kernel_launch(void* const* d_in, const int* in_sizes, int n_in, void* d_out, int out_size, void* d_ws, size_t ws_size, hipStream_t stream) {
  static int grid_blocks = 0;
  if (grid_blocks == 0) {
    if (n_in != 27 || ws_size < WS_END) { fprintf(stderr, "kernel_launch: expected 27 inputs and >= %zu bytes of workspace (got %d, %zu)\n", (size_t)WS_END, n_in, ws_size); grid_blocks = -1; return; }
    int dev = 0, cus = 0, per_cu = 0;
    hipGetDevice(&dev);
    hipDeviceGetAttribute(&cus, hipDeviceAttributeMultiprocessorCount, dev);
    hipFuncSetAttribute((const void*)hybrid_fwd, hipFuncAttributeMaxDynamicSharedMemorySize, SMEM_BYTES);
    hipOccupancyMaxActiveBlocksPerMultiprocessor(&per_cu, hybrid_fwd, 256, SMEM_BYTES);
    if (per_cu < 1) per_cu = 1;
    if (per_cu > 2) per_cu = 2;
    grid_blocks = cus * per_cu;
    if (grid_blocks < 512) { fprintf(stderr, "kernel_launch: needs 512 co-resident blocks, got %d\n", grid_blocks); grid_blocks = -1; return; }
    grid_blocks = 512;
    fprintf(stderr, "kernel_launch: cus %d per_cu %d grid %d\n", cus, per_cu, grid_blocks);
  }
  if (grid_blocks < 0) return;
  Params p;
  memset(&p, 0, sizeof(p));
  const float** pp = (const float**)&p;
  for (int i = 0; i < 27; ++i) pp[i] = (const float*)d_in[i];
  p.out = (float*)d_out;
  p.ws = (unsigned char*)d_ws;
#if N_LAUNCH_MODE == 1
  p.ph_lo = 0; p.ph_hi = NPH;
  hipMemsetAsync((unsigned char*)d_ws + OFF_BAR, 0, 16384 + 131072, stream);
  void* args[] = {&p};
  hipError_t e = hipLaunchCooperativeKernel((void*)hybrid_fwd, dim3(grid_blocks), dim3(256), args, SMEM_BYTES, stream);
  if (e != hipSuccess) fprintf(stderr, "cooperative launch failed: %s (grid %d)\n", hipGetErrorString(e), grid_blocks);
#else
  for (int ph = 0; ph < NPH; ++ph) {
    p.ph_lo = ph; p.ph_hi = ph + 1;
    hipLaunchKernelGGL(hybrid_fwd, dim3(grid_blocks), dim3(256), SMEM_BYTES, stream, p);
  }
#endif
}
```

```cpp
#include <hip/hip_runtime.h>
#include <hip/hip_cooperative_groups.h>
#include <cstdio>
#include <cstdint>
#include <cstring>
namespace cg = cooperative_groups;

#ifndef N_LAUNCH_MODE
#define N_LAUNCH_MODE 1
#endif

typedef __attribute__((ext_vector_type(8))) short bf16x8;
typedef __attribute__((ext_vector_type(4))) short s16x4;
typedef __attribute__((ext_vector_type(4))) float f32x4;
typedef __attribute__((ext_vector_type(2))) float f32x2;
typedef __attribute__((ext_vector_type(16))) float f32x16;
typedef __attribute__((ext_vector_type(2))) __bf16 bf16x2_t;
typedef unsigned short u16;
typedef __attribute__((ext_vector_type(4))) unsigned u32x4;
typedef __attribute__((ext_vector_type(2))) unsigned u32x2;
#define DI __device__ __forceinline__
#define MFMA32(a, b, c) __builtin_amdgcn_mfma_f32_32x32x16_bf16((a), (b), (c), 0, 0, 0)
#define MFMA16(a, b, c) __builtin_amdgcn_mfma_f32_16x16x32_bf16((a), (b), (c), 0, 0, 0)

static constexpr int TT = 4352;
static constexpr int MROWS = 4 * TT;
static constexpr int NPH = 11;

static constexpr size_t OFF_WT0 = 0;
static constexpr size_t OFF_WT1 = OFF_WT0 + 7340032;
static constexpr size_t OFF_WT2 = OFF_WT1 + 2097152;
static constexpr size_t OFF_WT3 = OFF_WT2 + 5242880;
static constexpr size_t OFF_MOD = OFF_WT3 + 2097152;
static constexpr size_t OFF_HX  = OFF_MOD + 131072;
static constexpr size_t OFF_Q   = OFF_HX + 35651584;
static constexpr size_t OFF_KB  = OFF_Q + 35651584;
static constexpr size_t OFF_VT  = OFF_KB + 8912896;
static constexpr size_t OFF_PB  = OFF_VT + 8912896;
static constexpr size_t OFF_G   = OFF_PB + 62390272;
static constexpr size_t OFF_OB  = OFF_G + 35651584;
static constexpr size_t OFF_VSH = OFF_OB + 35651584;
static constexpr size_t OFF_BONS = OFF_VSH + 17825792;
static constexpr size_t OFF_BAR = OFF_BONS + 1114112;
static constexpr size_t OFF_FLAGS = OFF_BAR + 16384;
static constexpr size_t WS_END  = OFF_FLAGS + 131072;
static constexpr size_t OFF_Y   = OFF_PB;

struct Params {
  const float *x, *c, *ctx, *c_ctx, *w_mod, *b_mod, *g_pre, *g_post, *w_in_even, *w_out_even, *qn_a, *kn_a,
      *mu_b, *w0_b, *w2_b, *a0_b, *a2_b, *kk_b, *ka_b, *rk_b, *gn_w_b, *gn_b_b, *w_in_odd, *w_out_odd, *qn_c, *kn_c, *sink_c;
  float* out;
  unsigned char* ws;
  int ph_lo, ph_hi;
};

DI u32x4 mk4(unsigned a, unsigned b, unsigned c, unsigned d) { u32x4 v = {a, b, c, d}; return v; }
DI u32x2 mk2(unsigned a, unsigned b) { u32x2 v = {a, b}; return v; }
DI unsigned pk2(float lo, float hi) { f32x2 v = {lo, hi}; bf16x2_t b = __builtin_convertvector(v, bf16x2_t); return __builtin_bit_cast(unsigned, b); }
DI u16 bf1(float x) { return (u16)(pk2(x, 0.f) & 0xffffu); }
DI float bf_lo(unsigned u) { return __uint_as_float(u << 16); }
DI float bf_hi(unsigned u) { return __uint_as_float(u & 0xffff0000u); }
template <int CTRL> DI float dppf(float x) { return __int_as_float(__builtin_amdgcn_update_dpp(0, __float_as_int(x), CTRL, 0xF, 0xF, true)); }
DI float reduce16(float x) { x += dppf<0xB1>(x); x += dppf<0x4E>(x); x += dppf<0x124>(x); x += dppf<0x128>(x); return x; }
DI float reduce8(float x) { x += dppf<0xB1>(x); x += dppf<0x4E>(x); x += dppf<0x141>(x); return x; }
DI float wave_sum(float x) { for (int o = 32; o >= 1; o >>= 1) x += __shfl_xor(x, o); return x; }
DI float silu(float v) { return v / (1.f + __expf(-v)); }
DI float fexp2(float x) { return __builtin_amdgcn_exp2f(x); }


#define XB_TMO      128
#define XB_XCNT(j)  (256  + 64 * (j))
#define XB_XSUB(j)  (1280 + 64 * (j))
#define XB_XGEN(j)  (2304 + 64 * (j))
#define XB_TOP      3328
#define XB_TOPGEN   3392
#define XCD_BAR_WORDS 3456
#define XB_SPIN_CAP (1u << 20)
#define LAS __attribute__((address_space(3)))
DI unsigned xb_ld(unsigned* p) { return __hip_atomic_load(p, __ATOMIC_RELAXED, __HIP_MEMORY_SCOPE_AGENT); }
DI unsigned xb_add(unsigned* p, unsigned v) { return __hip_atomic_fetch_add(p, v, __ATOMIC_RELAXED, __HIP_MEMORY_SCOPE_AGENT); }
DI unsigned xb_xcc_id() { return (unsigned)__builtin_amdgcn_s_getreg((3 << 11) | 20) & 0xFu; }
#define XB_SPIN(cond, bar) do { unsigned _sp = 0; while (cond) { __builtin_amdgcn_s_sleep(1); \
    if ((++_sp & 255u) == 0u) { if (xb_ld(&(bar)[XB_TMO])) break; if (_sp > XB_SPIN_CAP) { atomicAdd(&(bar)[XB_TMO], 1u); break; } } } } while (0)
struct XcdBarrier { unsigned* bar; unsigned x; volatile LAS unsigned* st; };
DI XcdBarrier xcd_barrier_post(unsigned* bar, volatile LAS unsigned* st) {
  XcdBarrier b; b.bar = bar; b.x = xb_xcc_id(); b.st = st;
  if (threadIdx.x == 0) st[2] = xb_add(&bar[XB_XCNT(b.x)], 1u);
  return b;
}
DI void xcd_barrier_complete(unsigned* bar, unsigned x, unsigned& nloc, unsigned& nx) {
  const unsigned G = gridDim.x * gridDim.y * gridDim.z;
  unsigned sum, cnt, mine, sp = 0u;
  for (;;) {
    sum = 0u; cnt = 0u; mine = 0u;
#pragma unroll
    for (unsigned j = 0; j < 16; ++j) { const unsigned c = xb_ld(&bar[XB_XCNT(j)]); sum += c; cnt += (c > 0u) ? 1u : 0u; mine = (j == x) ? c : mine; }
    if (sum == G) break;
    __builtin_amdgcn_s_sleep(1);
    if ((++sp & 255u) == 0u) { if (xb_ld(&bar[XB_TMO])) break; if (sp > XB_SPIN_CAP) { atomicAdd(&bar[XB_TMO], 1u); break; } }
  }
  nloc = mine > 0u ? mine : 1u; nx = cnt > 0u ? cnt : 1u;
}
DI void xcd_barrier(const XcdBarrier& b) {
  asm volatile("s_waitcnt vmcnt(0)" ::: "memory");
  __syncthreads();
  if (threadIdx.x == 0) {
    unsigned* bar = b.bar;
    __builtin_amdgcn_s_waitcnt(0);
    unsigned nloc = b.st[0], nx = b.st[1];
    if (nloc == 0u) { xcd_barrier_complete(bar, b.x, nloc, nx); b.st[0] = nloc; b.st[1] = nx; }
    const unsigned old = xb_add(&bar[XB_XSUB(b.x)], 1u);
    const unsigned gen = old / nloc;
    if (old + 1u == (gen + 1u) * nloc) {
      __builtin_amdgcn_fence(__ATOMIC_RELEASE, "agent");
      asm volatile("s_waitcnt vmcnt(0)" ::: "memory");
      const unsigned og = xb_add(&bar[XB_TOP], 1u);
      const unsigned tg = og / nx;
      if (og + 1u == (tg + 1u) * nx) xb_add(&bar[XB_TOPGEN], 1u);
      else XB_SPIN(xb_ld(&bar[XB_TOPGEN]) == tg, bar);
      __builtin_amdgcn_fence(__ATOMIC_ACQUIRE, "agent");
      xb_add(&bar[XB_XGEN(b.x)], 1u);
      asm volatile("s_waitcnt vmcnt(0)" ::: "memory");
    } else {
      XB_SPIN(xb_ld(&bar[XB_XGEN(b.x)]) == gen, bar);
      __builtin_amdgcn_fence(__ATOMIC_ACQUIRE, "agent");
      asm volatile("s_waitcnt vmcnt(0)" ::: "memory");
    }
  }
  __syncthreads();
}

#define DPP_ADD(name, ctrl) DI float name(float x) { float r; asm("s_nop 1\n\tv_add_f32_dpp %0, %1, %1 " ctrl " row_mask:0xf bank_mask:0xf" : "=v"(r) : "v"(x)); return r; }
DPP_ADD(dpa_x1, "quad_perm:[1,0,3,2]")
DPP_ADD(dpa_x2, "quad_perm:[2,3,0,1]")
DPP_ADD(dpa_hm, "row_half_mirror")
DPP_ADD(dpa_r4, "row_ror:4")
DPP_ADD(dpa_r8, "row_ror:8")
template <int LPR> DI float red_lpr(float x) {
  x = dpa_x1(x); x = dpa_x2(x);
  if (LPR == 8) x = dpa_hm(x); else { x = dpa_r4(x); x = dpa_r8(x); }
  return x;
}

DI void phase_prep(const Params& p, char* smem, int vb, int nvb) {
  const int tid = threadIdx.x;
  float* tile = (float*)smem;
  float* sc = (float*)smem;
  float* part = sc + 5120;
  for (int u = vb; u < 2048 + 384; u += nvb) {
    if (u < 2048) {
      int ti = u; const float* W; u16* Wt; int N;
      if (ti < 896) { W = p.w_in_even; Wt = (u16*)(p.ws + OFF_WT0); N = 3584; }
      else if (ti < 1152) { ti -= 896; W = p.w_out_even; Wt = (u16*)(p.ws + OFF_WT1); N = 1024; }
      else if (ti < 1792) { ti -= 1152; W = p.w_in_odd; Wt = (u16*)(p.ws + OFF_WT2); N = 2560; }
      else { ti -= 1792; W = p.w_out_odd; Wt = (u16*)(p.ws + OFF_WT3); N = 1024; }
      const int ntn = N >> 6;
      const int kt = ti / ntn, nt = ti - kt * ntn;
#pragma unroll
      for (int ps = 0; ps < 4; ++ps) {
        const int row = (tid >> 4) + 16 * ps, c4 = (tid & 15) * 4;
        const f32x4 v = *(const f32x4*)(W + (size_t)(kt * 64 + row) * N + nt * 64 + c4);
        tile[row * 65 + c4 + 0] = v[0]; tile[row * 65 + c4 + 1] = v[1]; tile[row * 65 + c4 + 2] = v[2]; tile[row * 65 + c4 + 3] = v[3];
      }
      __syncthreads();
      const int n = tid >> 2, kq = (tid & 3) * 16;
      unsigned o[8];
#pragma unroll
      for (int j = 0; j < 8; ++j) o[j] = pk2(tile[(kq + 2 * j) * 65 + n], tile[(kq + 2 * j + 1) * 65 + n]);
      u32x4* dst = (u32x4*)(Wt + (size_t)(nt * 64 + n) * 1024 + kt * 64 + kq);
      dst[0] = mk4(o[0], o[1], o[2], o[3]);
      dst[1] = mk4(o[4], o[5], o[6], o[7]);
      __syncthreads();
    } else {
      const int u2 = u - 2048;
      const int l = u2 / 192, cb = u2 - l * 192;
      for (int idx = tid; idx < 5120; idx += 256) {
        const int s = idx >> 10, k = idx & 1023;
        const float v = (s < 4) ? p.c[s * 1024 + k] : p.c_ctx[k];
        sc[idx] = v / (1.f + expf(-v));
      }
      __syncthreads();
      const int col = tid & 15, kg = tid >> 4;
      float acc[5] = {0.f, 0.f, 0.f, 0.f, 0.f};
      const float* wp = p.w_mod + ((size_t)l * 1024 + kg * 64) * 3072 + cb * 16 + col;
#pragma unroll 16
      for (int k = 0; k < 64; ++k) {
        const float wv = wp[(size_t)k * 3072];
#pragma unroll
        for (int s = 0; s < 5; ++s) acc[s] += sc[s * 1024 + kg * 64 + k] * wv;
      }
#pragma unroll
      for (int s = 0; s < 5; ++s) part[(kg * 5 + s) * 16 + col] = acc[s];
      __syncthreads();
      if (tid < 80) {
        const int s = tid >> 4, cc = tid & 15;
        float a = 0.f;
        for (int g = 0; g < 16; ++g) a += part[(g * 5 + s) * 16 + cc];
        float* MOD = (float*)(p.ws + OFF_MOD);
        MOD[(l * 5 + s) * 3072 + cb * 16 + cc] = a + p.b_mod[l * 3072 + cb * 16 + cc];
      }
      __syncthreads();
    }
  }
}

DI void phase_prenorm0(const Params& p, int vb, int nvb) {
  const int tid = threadIdx.x, lane = tid & 63, w = tid >> 6;
  const float* MOD = (const float*)(p.ws + OFF_MOD);
  u16* HX = (u16*)(p.ws + OFF_HX);
  for (int u = vb; u < MROWS / 4; u += nvb) {
    const int rowg = u * 4 + w;
    const int b = rowg / TT, tok = rowg - b * TT;
    const bool lat = tok < 4096;
    const float* src = lat ? p.x + ((size_t)b * 4096 + tok) * 1024 : p.ctx + ((size_t)b * 256 + (tok - 4096)) * 1024;
    const float* mod = MOD + (0 * 5 + (lat ? b : 4)) * 3072;
    f32x4 v[4]; float ss = 0.f;
#pragma unroll
    for (int j = 0; j < 4; ++j) { v[j] = __builtin_nontemporal_load((const f32x4*)(src + j * 256 + lane * 4)); ss += v[j][0] * v[j][0] + v[j][1] * v[j][1] + v[j][2] * v[j][2] + v[j][3] * v[j][3]; }
    ss = wave_sum(ss);
    const float rinv = rsqrtf(ss * (1.f / 1024.f) + 1e-6f);
#pragma unroll
    for (int j = 0; j < 4; ++j) {
      const int col = j * 256 + lane * 4;
      const f32x4 g = *(const f32x4*)(p.g_pre + col), sh = *(const f32x4*)(mod + col), scv = *(const f32x4*)(mod + 1024 + col);
      float hv[4];
#pragma unroll
      for (int e = 0; e < 4; ++e) hv[e] = (v[j][e] * rinv * g[e]) * (1.f + scv[e]) + sh[e];
      *(u32x2*)(HX + (size_t)rowg * 1024 + col) = mk2(pk2(hv[0], hv[1]), pk2(hv[2], hv[3]));
    }
  }
}

template <int MODE>
DI void gemm_phase(const Params& p, char* smem, int vb, int nvb, const u16* __restrict__ Wt, const u16* __restrict__ X, int NT) {
  u16* As = (u16*)smem;
  u16* Bs = As + 2 * 128 * 72;
  const int tid = threadIdx.x, lane = tid & 63, w = tid >> 6, r = lane & 31, h = lane >> 5;
  const int wn = w & 1, wt = w >> 1;
  const int total = 136 * NT;
  const int NB4 = NT >> 2;
  for (int u = vb; u < total; u += nvb) {
    const int blk = u >> 5, wi = u & 31;
    const int mbk = blk / NB4, nbk = blk - mbk * NB4;
    const int mt = mbk * 8 + (wi >> 2), nt = nbk * 4 + (wi & 3);
    const bool ctx_tile = (mt % 34) >= 32;
    if (MODE == 2 && ctx_tile && (nt < 8 || nt >= 12)) continue;
    if (MODE == 3 && ctx_tile) continue;
    const u16* Wg = Wt + (size_t)(nt * 128) * 1024;
    const u16* Xg = X + (size_t)(mt * 128) * 1024;
    f32x16 acc[2][2];
#pragma unroll
    for (int a = 0; a < 2; ++a)
#pragma unroll
      for (int bq = 0; bq < 2; ++bq)
#pragma unroll
        for (int i = 0; i < 16; ++i) acc[a][bq][i] = 0.f;
    u32x4 ra[4], rb[4];
#define GEMM_LOAD(KT)                                                                                     \
    {                                                                                                     \
      _Pragma("unroll") for (int j = 0; j < 4; ++j) {                                                     \
        const int cidx = tid + 256 * j, row = cidx >> 3, part = cidx & 7;                                 \
        ra[j] = *(const u32x4*)(Wg + (size_t)row * 1024 + (KT) * 64 + part * 8);                          \
        rb[j] = *(const u32x4*)(Xg + (size_t)row * 1024 + (KT) * 64 + part * 8);                          \
      }                                                                                                   \
    }
#define GEMM_STORE(BUF)                                                                                   \
    {                                                                                                     \
      _Pragma("unroll") for (int j = 0; j < 4; ++j) {                                                     \
        const int cidx = tid + 256 * j, row = cidx >> 3, part = cidx & 7;                                 \
        *(u32x4*)(As + (BUF) * 9216 + row * 72 + part * 8) = ra[j];                                      \
        *(u32x4*)(Bs + (BUF) * 9216 + row * 72 + part * 8) = rb[j];                                      \
      }                                                                                                   \
    }
    GEMM_LOAD(0)
    GEMM_STORE(0)
    GEMM_LOAD(1)
    __syncthreads();
    for (int kt = 0; kt < 16; ++kt) {
      const int cbuf = kt & 1;
      const u16* Ac = As + cbuf * 9216;
      const u16* Bc = Bs + cbuf * 9216;
      __builtin_amdgcn_s_setprio(1);
#pragma unroll
      for (int ks = 0; ks < 4; ++ks) {
        const bf16x8 a0 = *(const bf16x8*)(Ac + (wn * 64 + r) * 72 + ks * 16 + h * 8);
        const bf16x8 a1 = *(const bf16x8*)(Ac + (wn * 64 + 32 + r) * 72 + ks * 16 + h * 8);
        const bf16x8 b0 = *(const bf16x8*)(Bc + (wt * 64 + r) * 72 + ks * 16 + h * 8);
        const bf16x8 b1 = *(const bf16x8*)(Bc + (wt * 64 + 32 + r) * 72 + ks * 16 + h * 8);
        acc[0][0] = MFMA32(a0, b0, acc[0][0]);
        acc[0][1] = MFMA32(a0, b1, acc[0][1]);
        acc[1][0] = MFMA32(a1, b0, acc[1][0]);
        acc[1][1] = MFMA32(a1, b1, acc[1][1]);
      }
      __builtin_amdgcn_sched_group_barrier(0x100, 4, 0);
#pragma unroll
      for (int q = 0; q < 12; ++q) { __builtin_amdgcn_sched_group_barrier(0x008, 1, 0); __builtin_amdgcn_sched_group_barrier(0x100, 1, 0); }
      __builtin_amdgcn_sched_group_barrier(0x008, 4, 0);
      __builtin_amdgcn_s_setprio(0);
      __builtin_amdgcn_sched_barrier(0);
      if (kt + 1 < 16) GEMM_STORE(cbuf ^ 1)
      if (kt + 2 < 16) GEMM_LOAD(kt + 2)
      __syncthreads();
    }
#undef GEMM_LOAD
#undef GEMM_STORE
    const int nbase = nt * 128 + wn * 64;
    if (MODE == 1 || MODE == 3) {
      u16* Y = (u16*)(p.ws + OFF_Y);
#pragma unroll
      for (int tb = 0; tb < 2; ++tb) {
        const int rowg = mt * 128 + wt * 64 + tb * 32 + r;
#pragma unroll
        for (int nb = 0; nb < 2; ++nb)
#pragma unroll
          for (int ig = 0; ig < 4; ++ig) {
            *(u32x2*)(Y + (size_t)rowg * 1024 + nbase + nb * 32 + 8 * ig + 4 * h) =
                mk2(pk2(acc[nb][tb][4 * ig], acc[nb][tb][4 * ig + 1]), pk2(acc[nb][tb][4 * ig + 2], acc[nb][tb][4 * ig + 3]));
          }
      }
    } else {
      const int seg = nbase >> 6;
      int kind, hidx, QP, Gn, gateoff; const float* gain;
      if (MODE == 0) {
        QP = 512; Gn = 2;
        if (seg < 8) { kind = 0; hidx = seg; gain = p.qn_a; }
        else if (seg < 10) { kind = 1; hidx = seg - 8; gain = p.kn_a; }
        else if (seg < 12) { kind = 2; hidx = seg - 10; gain = nullptr; }
        else if (seg < 40) { kind = 3; hidx = 0; gain = nullptr; }
        else { kind = 4; hidx = 0; gain = nullptr; }
        gateoff = 2560;
      } else {
        QP = 1024; Gn = 4;
        if (seg < 16) { kind = 0; hidx = seg; gain = p.qn_c; }
        else if (seg < 20) { kind = 1; hidx = seg - 16; gain = p.kn_c; }
        else if (seg < 24) { kind = 2; hidx = seg - 20; gain = nullptr; }
        else { kind = 4; hidx = 0; gain = nullptr; }
        gateoff = 1536;
      }
      u16* Q = (u16*)(p.ws + OFF_Q);
      u16* KB = (u16*)(p.ws + OFF_KB);
      u16* VT = (u16*)(p.ws + OFF_VT);
      u16* PB = (u16*)(p.ws + OFF_PB);
      u16* G = (u16*)(p.ws + OFF_G);
#pragma unroll
      for (int tb = 0; tb < 2; ++tb) {
        const int rowg = mt * 128 + wt * 64 + tb * 32 + r;
        const int b = rowg / TT, tok = rowg - b * TT;
        const bool lat = tok < 4096;
        if (kind <= 1) {
          float ss = 0.f;
#pragma unroll
          for (int nb = 0; nb < 2; ++nb)
#pragma unroll
            for (int i = 0; i < 16; ++i) ss += acc[nb][tb][i] * acc[nb][tb][i];
          ss += __shfl_xor(ss, 32);
          const float rinv = rsqrtf(ss * (1.f / 64.f) + 1e-6f);
          const float prow = (float)(tok >> 6), pcol = (float)(tok & 63);
          const float osc = (kind == 0) ? 0.125f * 1.4426950408889634f : 1.f;
#pragma unroll
          for (int nb = 0; nb < 2; ++nb)
#pragma unroll
            for (int ig = 0; ig < 4; ++ig) {
              const int nin = nb * 32 + 8 * ig + 4 * h;
              const f32x4 gv = *(const f32x4*)(gain + nin);
              float xv[4];
#pragma unroll
              for (int e = 0; e < 4; ++e) xv[e] = acc[nb][tb][4 * ig + e] * rinv * gv[e];
              if (lat) {
#pragma unroll
                for (int pr = 0; pr < 2; ++pr) {
                  const int j = 4 * ig + 2 * h + pr;
                  const float ang = (nb == 0 ? prow : pcol) * exp2f(-(float)j * 0.8304820237218405f);
                  const float cs = __cosf(ang), sn = __sinf(ang);
                  const float x1 = xv[2 * pr], x2 = xv[2 * pr + 1];
                  xv[2 * pr] = x1 * cs - x2 * sn;
                  xv[2 * pr + 1] = x1 * sn + x2 * cs;
                }
              }
              const u32x2 o = mk2(pk2(xv[0] * osc, xv[1] * osc), pk2(xv[2] * osc, xv[3] * osc));
              if (kind == 0) *(u32x2*)(Q + (size_t)rowg * QP + hidx * 64 + nin) = o;
              else *(u32x2*)(KB + ((size_t)(b * Gn + hidx) * TT + tok) * 64 + nin) = o;
            }
        } else if (kind == 2) {
#pragma unroll
          for (int nb = 0; nb < 2; ++nb)
#pragma unroll
            for (int i = 0; i < 16; ++i) {
              const int dd = nb * 32 + (i & 3) + 8 * (i >> 2) + 4 * h;
              VT[((size_t)(b * Gn + hidx) * 64 + dd) * TT + tok] = bf1(acc[nb][tb][i]);
            }
        } else if (kind == 3) {
#pragma unroll
          for (int nb = 0; nb < 2; ++nb)
#pragma unroll
            for (int ig = 0; ig < 4; ++ig)
              *(u32x2*)(PB + (size_t)rowg * 1792 + (nbase - 768) + nb * 32 + 8 * ig + 4 * h) =
                  mk2(pk2(acc[nb][tb][4 * ig], acc[nb][tb][4 * ig + 1]), pk2(acc[nb][tb][4 * ig + 2], acc[nb][tb][4 * ig + 3]));
        } else {
#pragma unroll
          for (int nb = 0; nb < 2; ++nb)
#pragma unroll
            for (int ig = 0; ig < 4; ++ig)
              *(u32x2*)(G + (size_t)rowg * 1024 + (nbase - gateoff) + nb * 32 + 8 * ig + 4 * h) =
                  mk2(pk2(silu(acc[nb][tb][4 * ig]), silu(acc[nb][tb][4 * ig + 1])), pk2(silu(acc[nb][tb][4 * ig + 2]), silu(acc[nb][tb][4 * ig + 3])));
        }
      }
    }
  }
}

DI void attn_block(const Params& p, char* smem, int QP, int Gn, int b, int head, int qtok0,
                   int t_first, int n_first, int t_second, int n_second, bool win, bool has_sink, float sink2) {
  u16* Ks = (u16*)smem;
  u16* Vs = Ks + 64 * 72;
  const u16* Q = (const u16*)(p.ws + OFF_Q);
  const u16* G = (const u16*)(p.ws + OFF_G);
  u16* A2 = (u16*)(p.ws + OFF_HX);
  const int tid = threadIdx.x, lane = tid & 63, w = tid >> 6, r = lane & 31, h = lane >> 5;
  const int g = head >> 2;
  const u16* Kg = (const u16*)(p.ws + OFF_KB) + (size_t)(b * Gn + g) * TT * 64;
  const u16* Vg = (const u16*)(p.ws + OFF_VT) + (size_t)(b * Gn + g) * 64 * TT;
  const int qtok = qtok0 + w * 32 + r;
  const size_t qrow = (size_t)b * TT + qtok;
  bf16x8 qf[4];
#pragma unroll
  for (int ks = 0; ks < 4; ++ks) qf[ks] = *(const bf16x8*)(Q + qrow * QP + head * 64 + ks * 16 + h * 8);
  f32x16 o[2];
#pragma unroll
  for (int db = 0; db < 2; ++db)
#pragma unroll
    for (int i = 0; i < 16; ++i) o[db][i] = 0.f;
  float m = -INFINITY, l = 0.f;
  const int ntot = n_first + n_second;
  u32x4 rk[2], rv[2];
  {
    const int tile = (0 < n_first) ? t_first : t_second;
#pragma unroll
    for (int j = 0; j < 2; ++j) {
      const int cidx = tid + 256 * j, row = cidx >> 3, part = cidx & 7;
      rk[j] = *(const u32x4*)(Kg + (size_t)(tile * 64 + row) * 64 + part * 8);
      rv[j] = *(const u32x4*)(Vg + (size_t)row * TT + tile * 64 + part * 8);
    }
  }
  for (int it = 0; it < ntot; ++it) {
    const int tile = (it < n_first) ? (t_first + it) : (t_second + it - n_first);
    __syncthreads();
#pragma unroll
    for (int j = 0; j < 2; ++j) {
      const int cidx = tid + 256 * j, row = cidx >> 3, part = cidx & 7;
      *(u32x4*)(Ks + row * 72 + part * 8) = rk[j];
      *(u32x4*)(Vs + row * 72 + part * 8) = rv[j];
    }
    __syncthreads();
    if (it + 1 < ntot) {
      const int tn = (it + 1 < n_first) ? (t_first + it + 1) : (t_second + it + 1 - n_first);
#pragma unroll
      for (int j = 0; j < 2; ++j) {
        const int cidx = tid + 256 * j, row = cidx >> 3, part = cidx & 7;
        rk[j] = *(const u32x4*)(Kg + (size_t)(tn * 64 + row) * 64 + part * 8);
        rv[j] = *(const u32x4*)(Vg + (size_t)row * TT + tn * 64 + part * 8);
      }
    }
    __builtin_amdgcn_sched_barrier(0);
    const int qw0 = qtok0 + w * 32;
    const bool live = !win || tile >= 64 || (tile * 64 <= qw0 + 31 + 128 && tile * 64 + 63 >= qw0 - 128);
    if (live) {
    f32x16 s[2];
#pragma unroll
    for (int kb = 0; kb < 2; ++kb) {
#pragma unroll
      for (int i = 0; i < 16; ++i) s[kb][i] = 0.f;
#pragma unroll
      for (int ks = 0; ks < 4; ++ks) {
        const bf16x8 a = *(const bf16x8*)(Ks + (kb * 32 + r) * 72 + ks * 16 + h * 8);
        s[kb] = MFMA32(a, qf[ks], s[kb]);
      }
    }
    if (win && tile < 64) {
#pragma unroll
      for (int kb = 0; kb < 2; ++kb)
#pragma unroll
        for (int i = 0; i < 16; ++i) {
          const int key = tile * 64 + kb * 32 + (i & 3) + 8 * (i >> 2) + 4 * h;
          const int dl = key - qtok;
          if (dl > 128 || dl < -128) s[kb][i] = -INFINITY;
        }
    }
    float mx = -INFINITY;
#pragma unroll
    for (int kb = 0; kb < 2; ++kb)
#pragma unroll
      for (int i = 0; i < 16; ++i) mx = fmaxf(mx, s[kb][i]);
    mx = fmaxf(mx, __shfl_xor(mx, 32));
    float alpha = 1.f;
    if (!__all(mx - m <= 8.f)) {
      const float mn = fmaxf(m, mx);
      alpha = fexp2(m - mn);
      m = mn;
#pragma unroll
      for (int db = 0; db < 2; ++db)
#pragma unroll
        for (int i = 0; i < 16; ++i) o[db][i] *= alpha;
    }
    float ps = 0.f;
#pragma unroll
    for (int kb = 0; kb < 2; ++kb)
#pragma unroll
      for (int i = 0; i < 16; ++i) { s[kb][i] = fexp2(s[kb][i] - m); ps += s[kb][i]; }
    l = l * alpha + ps;
#pragma unroll
    for (int kb = 0; kb < 2; ++kb)
#pragma unroll
      for (int st = 0; st < 2; ++st) {
        const unsigned p0 = pk2(s[kb][8 * st + 0], s[kb][8 * st + 1]), p1 = pk2(s[kb][8 * st + 2], s[kb][8 * st + 3]);
        const unsigned p2 = pk2(s[kb][8 * st + 4], s[kb][8 * st + 5]), p3 = pk2(s[kb][8 * st + 6], s[kb][8 * st + 7]);
        const u32x4 pu = mk4(p0, p1, p2, p3);
        const bf16x8 pf = __builtin_bit_cast(bf16x8, pu);
#pragma unroll
        for (int db = 0; db < 2; ++db) {
          const s16x4 lo = *(const s16x4*)(Vs + (db * 32 + r) * 72 + kb * 32 + 16 * st + 4 * h);
          const s16x4 hi = *(const s16x4*)(Vs + (db * 32 + r) * 72 + kb * 32 + 16 * st + 8 + 4 * h);
          const bf16x8 vf = __builtin_shufflevector(lo, hi, 0, 1, 2, 3, 4, 5, 6, 7);
          o[db] = MFMA32(vf, pf, o[db]);
        }
      }
    }
  }
  l += __shfl_xor(l, 32);
  if (has_sink) {
    const float mn = fmaxf(m, sink2);
    const float alpha = fexp2(m - mn);
    l = l * alpha + fexp2(sink2 - mn);
#pragma unroll
    for (int db = 0; db < 2; ++db)
#pragma unroll
      for (int i = 0; i < 16; ++i) o[db][i] *= alpha;
  }
  const float inv = 1.f / l;
#pragma unroll
  for (int db = 0; db < 2; ++db)
#pragma unroll
    for (int ig = 0; ig < 4; ++ig) {
      const int dd = db * 32 + 8 * ig + 4 * h;
      const u32x2 gt = *(const u32x2*)(G + qrow * 1024 + head * 64 + dd);
      const float v0 = o[db][4 * ig] * inv * bf_lo(gt.x), v1 = o[db][4 * ig + 1] * inv * bf_hi(gt.x);
      const float v2 = o[db][4 * ig + 2] * inv * bf_lo(gt.y), v3 = o[db][4 * ig + 3] * inv * bf_hi(gt.y);
      *(u32x2*)(A2 + qrow * 1024 + head * 64 + dd) = mk2(pk2(v0, v1), pk2(v2, v3));
    }
}

DI int scan_tok(int s, int d) {
  if (s < 256) return 4096 + (d ? 255 - s : s);
  const int i = s - 256;
  return d ? 4095 - i : i;
}

template <class T> DI T ldgo(const void* base, unsigned byteoff) { return *(const T*)((const char*)base + byteoff); }
DI int scan_segoff(int sg, int d, int h) { return sg < 3 ? sg * 512 + h * 64 : 1536 + (sg - 3) * 128 + d * 64; }
DI float frcp(float x) { return __builtin_amdgcn_rcpf(x); }
DI float tanh_fast(float x) { const float e = __expf(2.f * x); return 1.f - 2.f * frcp(e + 1.f); }

#define GAS __attribute__((address_space(1)))
typedef GAS unsigned long long gu64;
typedef GAS unsigned gu32;
static constexpr int RING = 21;
static constexpr int SLOT_F = 3200;
DI int rec_voff(int vec) { return vec * 64 + (vec >= 3 ? 64 : 0); }
static constexpr size_t OFF_RING = OFF_Q + 17825792;
DI unsigned flag_ld(unsigned* f) { return __hip_atomic_load(f, __ATOMIC_RELAXED, __HIP_MEMORY_SCOPE_AGENT); }
DI void flag_st(unsigned* f, unsigned v) { __hip_atomic_store(f, v, __ATOMIC_RELAXED, __HIP_MEMORY_SCOPE_AGENT); }
#define FLAG_PROD(chain, par) ((unsigned*)(p.ws + OFF_FLAGS) + ((chain) * 2 + (par)) * 64)
#define FLAG_CONS(chain, sp) ((unsigned*)(p.ws + OFF_FLAGS) + (128 + (chain) * 4 + (sp)) * 64)
#define FLAG_TMO ((unsigned*)(p.ws + OFF_FLAGS) + 384 * 64)
#define PC_WAIT(cond) do { unsigned _sp = 0; while (cond) { __builtin_amdgcn_s_sleep(1); \
    if ((++_sp & 1023u) == 0u) { if (flag_ld(FLAG_TMO)) break; if (_sp > (1u << 22)) { flag_st(FLAG_TMO, 1u); break; } } } } while (0)

#ifndef NPROD
#define NPROD 2
#endif
DI void scan_producer(const Params& p, char* smem, int chain, int par) {
  __builtin_amdgcn_s_setprio(2);
  const int tid = threadIdx.x, lane = tid & 63, w = tid >> 6;
  const int d = chain >> 5, b = (chain >> 3) & 3, h = chain & 7;
  float* REC = (float*)smem;
  float* RSs = REC + 8 * 768;
  float* KSs = RSs + 1024;
  float* INVN = KSs + 1024;
  float* SCP = INVN + 16;
  float* BONP = SCP + 128;
  float* CST = BONP + 64;
  u16* ZW = (u16*)(CST + 768);
  u16* ZA = ZW + 16 * 72;
  u16* RAW = ZA + 16 * 72;
  const u16* PB = (const u16*)(p.ws + OFF_PB);
  u16* VSH = (u16*)(p.ws + OFF_VSH);
  float* BONS = (float*)(p.ws + OFF_BONS);
  float* ring = (float*)(p.ws + OFF_RING) + (size_t)chain * RING * SLOT_F;

  if (tid < 64) {
    const unsigned hc = (unsigned)(h * 64 + tid) * 4u, dhc = (unsigned)(d * 512 + h * 64 + tid) * 4u;
#pragma unroll
    for (int sg = 0; sg < 5; ++sg) CST[sg * 64 + tid] = ldgo<float>(p.mu_b, (unsigned)(scan_segoff(sg, d, h) + tid) * 4u);
    CST[320 + tid] = ldgo<float>(p.kk_b, hc);
    CST[512 + tid] = ldgo<float>(p.w0_b, dhc);
    CST[576 + tid] = ldgo<float>(p.a0_b, dhc);
    CST[640 + tid] = ldgo<float>(p.ka_b, hc);
    CST[704 + tid] = ldgo<float>(p.rk_b, hc);
  }
  const int t1 = tid >> 4, q = tid & 15, c4 = q * 4;
  const int hhi = tid / 80, hsg = (tid % 80) >> 4;
  const int c2 = 16 * w + (lane & 15), tg = lane >> 4;
  bf16x8 bw[2], ba[2];
#pragma unroll
  for (int ks = 0; ks < 2; ++ks) {
    unsigned uw[4], ua[4];
#pragma unroll
    for (int e2 = 0; e2 < 4; ++e2) {
      const int j0 = tg * 8 + 32 * ks + 2 * e2;
      const unsigned o0 = (unsigned)((d * 64 + j0) * 512 + h * 64 + c2) * 4u;
      uw[e2] = pk2(ldgo<float>(p.w2_b, o0), ldgo<float>(p.w2_b, o0 + 2048u));
      ua[e2] = pk2(ldgo<float>(p.a2_b, o0), ldgo<float>(p.a2_b, o0 + 2048u));
    }
    bw[ks] = __builtin_bit_cast(bf16x8, mk4(uw[0], uw[1], uw[2], uw[3]));
    ba[ks] = __builtin_bit_cast(bf16x8, mk4(ua[0], ua[1], ua[2], ua[3]));
  }
  u32x2 pr[5], ph = mk2(0u, 0u);
  const unsigned pbase = (unsigned)(b * TT) * 3584u;
#define SCAN_LOAD(CH)                                                                                                   \
  {                                                                                                                     \
    const unsigned ro_ = pbase + (unsigned)scan_tok((CH) * 16 + t1, d) * 3584u + (unsigned)c4 * 2u;                     \
    _Pragma("unroll") for (int sg = 0; sg < 5; ++sg) pr[sg] = ldgo<u32x2>(PB, ro_ + (unsigned)scan_segoff(sg, d, h) * 2u); \
    if (tid < 160) {                                                                                                    \
      const int sh_ = hhi ? (CH) * 16 + 16 : (CH) * 16 - 1;                                                             \
      const bool valid_ = hhi ? (sh_ != 256 && sh_ != 4352) : (sh_ != -1 && sh_ != 255);                               \
      ph = mk2(0u, 0u);                                                                                                 \
      if (valid_) ph = ldgo<u32x2>(PB, pbase + (unsigned)scan_tok(sh_, d) * 3584u + (unsigned)(scan_segoff(hsg, d, h) + c4) * 2u); \
    }                                                                                                                   \
  }
  SCAN_LOAD(par)
  int pub = -1;
  for (int ch = par; ch < 272; ch += NPROD) {
#pragma unroll
    for (int sg = 0; sg < 5; ++sg) *(u32x2*)(RAW + (t1 + 1) * 320 + sg * 64 + c4) = pr[sg];
    if (tid < 160) *(u32x2*)(RAW + (hhi * 17) * 320 + hsg * 64 + c4) = ph;
    asm volatile("s_waitcnt vmcnt(0)" ::: "memory");
    __syncthreads();
    if (tid == 0 && pub >= 0) flag_st(FLAG_PROD(chain, par), (unsigned)(pub + 1));
    unsigned cseen = 0xffffffffu;
    if (ch >= RING && tid < 4) cseen = flag_ld(FLAG_CONS(chain, tid));
    const int tok = scan_tok(ch * 16 + t1, d);
    {
      float sv[5][4];
#pragma unroll
      for (int sg = 0; sg < 5; ++sg) {
        const u32x2 cu = *(const u32x2*)(RAW + (t1 + 1) * 320 + sg * 64 + c4);
        const u32x2 pu = *(const u32x2*)(RAW + t1 * 320 + sg * 64 + c4);
        const u32x2 nu = *(const u32x2*)(RAW + (t1 + 2) * 320 + sg * 64 + c4);
        const f32x4 mu = *(const f32x4*)(CST + sg * 64 + c4);
        const float c0 = bf_lo(cu.x), c1 = bf_hi(cu.x), c2v = bf_lo(cu.y), c3 = bf_hi(cu.y);
        const float n0 = 0.5f * (bf_lo(pu.x) + bf_lo(nu.x)), n1 = 0.5f * (bf_hi(pu.x) + bf_hi(nu.x));
        const float n2 = 0.5f * (bf_lo(pu.y) + bf_lo(nu.y)), n3 = 0.5f * (bf_hi(pu.y) + bf_hi(nu.y));
        sv[sg][0] = c0 + mu[0] * (n0 - c0); sv[sg][1] = c1 + mu[1] * (n1 - c1);
        sv[sg][2] = c2v + mu[2] * (n2 - c2v); sv[sg][3] = c3 + mu[3] * (n3 - c3);
      }
      *(f32x4*)(RSs + t1 * 64 + c4) = (f32x4){sv[0][0], sv[0][1], sv[0][2], sv[0][3]};
      *(f32x4*)(KSs + t1 * 64 + c4) = (f32x4){sv[1][0], sv[1][1], sv[1][2], sv[1][3]};
      {
        float* vp = REC + (t1 >> 1) * 768 + 576 + c4 * 2 + (t1 & 1);
        vp[0] = sv[2][0]; vp[2] = sv[2][1]; vp[4] = sv[2][2]; vp[6] = sv[2][3];
      }
      if (d == 0) *(u32x2*)(VSH + (size_t)(b * TT + tok) * 512 + h * 64 + c4) = mk2(pk2(sv[2][0], sv[2][1]), pk2(sv[2][2], sv[2][3]));
      *(u32x2*)(ZW + t1 * 72 + c4) = mk2(pk2(tanh_fast(sv[3][0]), tanh_fast(sv[3][1])), pk2(tanh_fast(sv[3][2]), tanh_fast(sv[3][3])));
      *(u32x2*)(ZA + t1 * 72 + c4) = mk2(pk2(sv[4][0], sv[4][1]), pk2(sv[4][2], sv[4][3]));
      const f32x4 kkc1 = *(const f32x4*)(CST + 320 + c4);
      float ssq = 0.f;
#pragma unroll
      for (int e = 0; e < 4; ++e) { const float kq = sv[1][e] * kkc1[e]; ssq += kq * kq; }
      ssq = reduce16(ssq);
      if (q == 0) INVN[t1] = frcp(fmaxf(sqrtf(ssq), 1e-12f));
    }
    if (ch + NPROD < 272) SCAN_LOAD(ch + NPROD)
    __syncthreads();
    {
      const bf16x8 az0 = *(const bf16x8*)(ZW + (lane & 15) * 72 + tg * 8), az1 = *(const bf16x8*)(ZW + (lane & 15) * 72 + tg * 8 + 32);
      const bf16x8 aa0 = *(const bf16x8*)(ZA + (lane & 15) * 72 + tg * 8), aa1 = *(const bf16x8*)(ZA + (lane & 15) * 72 + tg * 8 + 32);
      f32x4 xw = {0.f, 0.f, 0.f, 0.f}, xa = {0.f, 0.f, 0.f, 0.f};
      xw = MFMA16(az0, bw[0], xw); xw = MFMA16(az1, bw[1], xw);
      xa = MFMA16(aa0, ba[0], xa); xa = MFMA16(aa1, ba[1], xa);
      const float w0c = CST[512 + c2], a0c = CST[576 + c2], kkc2 = CST[320 + c2], kac = CST[640 + c2], rkc = CST[704 + c2];
      float wv[4], kkv[4], bvv[4], kmv[4], rv4[4];
#pragma unroll
      for (int i = 0; i < 4; ++i) {
        const int t = tg * 4 + i;
        const float sgw = frcp(1.f + __expf(-(w0c + xw[i])));
        wv[i] = __expf(-0.6065306597126334f * sgw);
        const float a = frcp(1.f + __expf(-(a0c + xa[i])));
        const float k = KSs[t * 64 + c2];
        rv4[i] = RSs[t * 64 + c2];
        kkv[i] = k * kkc2 * INVN[t];
        bvv[i] = kkv[i] * a;
        kmv[i] = k * (1.f + (a - 1.f) * kac);
        const float bop = reduce16(rv4[i] * kmv[i] * rkc);
        if ((lane & 15) == 0) BONP[t * 4 + w] = bop;
      }
#pragma unroll
      for (int j = 0; j < 2; ++j) {
        const int ia = 2 * j, ib = 2 * j + 1, pp = 2 * tg + j;
        float* R = REC + pp * 768;
        R[c2] = kkv[ia]; R[64 + c2] = wv[ia] * kkv[ib]; R[128 + c2] = wv[ia] * rv4[ia]; R[192 + c2] = wv[ia] * wv[ib];
        R[256 + c2] = bvv[ia] * wv[ib]; R[320 + c2] = kmv[ia] * wv[ib]; R[384 + c2] = bvv[ib]; R[448 + c2] = kmv[ib]; R[512 + c2] = rv4[ib];
        const float s1 = reduce16(bvv[ia] * kkv[ib]), s2 = reduce16(kmv[ia] * kkv[ib]);
        const float s3 = reduce16(bvv[ia] * rv4[ia]), s4 = reduce16(kmv[ia] * rv4[ia]);
        if ((lane & 15) == 0) { SCP[(pp * 4 + 0) * 4 + w] = s1; SCP[(pp * 4 + 1) * 4 + w] = s2; SCP[(pp * 4 + 2) * 4 + w] = s3; SCP[(pp * 4 + 3) * 4 + w] = s4; }
      }
    }
    __syncthreads();
    if (ch >= RING && tid < 4 && cseen < (unsigned)(ch - RING + 1)) PC_WAIT(flag_ld(FLAG_CONS(chain, tid)) < (unsigned)(ch - RING + 1));
    if (tid < 32) {
      const f32x4 v = *(const f32x4*)(SCP + tid * 4);
      REC[(tid >> 2) * 768 + 704 + (tid & 3)] = (v[0] + v[1]) + (v[2] + v[3]);
    } else if (tid < 48) {
      const int tt = tid - 32;
      const f32x4 v = *(const f32x4*)(BONP + tt * 4);
      BONS[(size_t)(d * MROWS + b * TT + scan_tok(ch * 16 + tt, d)) * 8 + h] = (v[0] + v[1]) + (v[2] + v[3]);
    }
    __syncthreads();
    {
      gu64* dst = (gu64*)(ring + (size_t)(ch % RING) * SLOT_F);
      {
        const int pp = tid >> 5, k = tid & 31;
        const f32x2 wv2 = *(const f32x2*)(REC + pp * 768 + 192 + 2 * k);
        __hip_atomic_store(dst + tid, (unsigned long long)__float_as_uint(wv2[0]) | ((unsigned long long)__float_as_uint(wv2[1]) << 32), __ATOMIC_RELAXED, __HIP_MEMORY_SCOPE_AGENT);
      }
#pragma unroll
      for (int n = 0; n < 4; ++n) {
        const int idx = n * 256 + tid, pp = idx >> 7, vec = (idx >> 4) & 7, k = idx & 15;
        const f32x4 v = *(const f32x4*)(REC + pp * 768 + rec_voff(vec) + 4 * k);
        __hip_atomic_store(dst + 256 + idx, (unsigned long long)pk2(v[0], v[1]) | ((unsigned long long)pk2(v[2], v[3]) << 32), __ATOMIC_RELAXED, __HIP_MEMORY_SCOPE_AGENT);
      }
      {
        const int pp = tid >> 5, k = tid & 31;
        const f32x4 v = *(const f32x4*)(REC + pp * 768 + 576 + 4 * k);
        __hip_atomic_store(dst + 1280 + tid, (unsigned long long)pk2(v[0], v[1]) | ((unsigned long long)pk2(v[2], v[3]) << 32), __ATOMIC_RELAXED, __HIP_MEMORY_SCOPE_AGENT);
      }
      if (tid < 16) {
        const f32x2 sv2 = *(const f32x2*)(REC + (tid >> 1) * 768 + 704 + 2 * (tid & 1));
        __hip_atomic_store(dst + 1536 + tid, (unsigned long long)__float_as_uint(sv2[0]) | ((unsigned long long)__float_as_uint(sv2[1]) << 32), __ATOMIC_RELAXED, __HIP_MEMORY_SCOPE_AGENT);
      }
    }
    pub = ch;
  }
  asm volatile("s_waitcnt vmcnt(0)" ::: "memory");
  __syncthreads();
  if (tid == 0 && pub >= 0) flag_st(FLAG_PROD(chain, par), (unsigned)(pub + 1));
  __builtin_amdgcn_s_setprio(0);
#undef SCAN_LOAD
}

DI void red16x2(float& x, float& y) {
  asm("s_nop 1\n\tv_add_f32_dpp %0, %0, %0 quad_perm:[1,0,3,2] row_mask:0xf bank_mask:0xf\n\tv_add_f32_dpp %1, %1, %1 quad_perm:[1,0,3,2] row_mask:0xf bank_mask:0xf\n\ts_nop 0\n\t"
      "v_add_f32_dpp %0, %0, %0 quad_perm:[2,3,0,1] row_mask:0xf bank_mask:0xf\n\tv_add_f32_dpp %1, %1, %1 quad_perm:[2,3,0,1] row_mask:0xf bank_mask:0xf\n\ts_nop 0\n\t"
      "v_add_f32_dpp %0, %0, %0 row_ror:4 row_mask:0xf bank_mask:0xf\n\tv_add_f32_dpp %1, %1, %1 row_ror:4 row_mask:0xf bank_mask:0xf\n\ts_nop 0\n\t"
      "v_add_f32_dpp %0, %0, %0 row_ror:8 row_mask:0xf bank_mask:0xf\n\tv_add_f32_dpp %1, %1, %1 row_ror:8 row_mask:0xf bank_mask:0xf"
      : "+v"(x), "+v"(y));
}
DI void scan_consumer(const Params& p, char* smem, int chain, int split) {
  constexpr int RPB = 16, RPW = 4, LPR = 16, YPT = RPB * LPR;
  __builtin_amdgcn_s_setprio(3);
  const int tid = threadIdx.x, lane = tid & 63, w = tid >> 6;
  const int d = chain >> 5, b = (chain >> 3) & 3, h = chain & 7;
  float* REC = (float*)smem;
  float* YB = REC + 8 * 768;
  u16* YR = (u16*)(p.ws + OFF_OB);
  const float* ring = (const float*)(p.ws + OFF_RING) + (size_t)chain * RING * SLOT_F;
  const int t1 = tid >> 4, q = tid & 15;
  const int g = lane & (LPR - 1), rowb0 = w * RPW + (lane / LPR);
  f32x2 S0 = {0.f, 0.f}, S1 = {0.f, 0.f};
  unsigned long long nxA[7], nxB[7];
#define CONS_ISSUE(NX, CH)                                                                                              \
  {                                                                                                                     \
    const gu64* src_ = (const gu64*)(ring + (size_t)((CH) % RING) * SLOT_F);                                            \
    _Pragma("unroll") for (int j = 0; j < 6; ++j) NX[j] = __hip_atomic_load(src_ + j * 256 + tid, __ATOMIC_RELAXED, __HIP_MEMORY_SCOPE_AGENT); \
    NX[6] = 0ull;                                                                                                       \
    if (tid < 16) NX[6] = __hip_atomic_load(src_ + 1536 + tid, __ATOMIC_RELAXED, __HIP_MEMORY_SCOPE_AGENT);             \
  }
#define CONS_INSTALL(NX)                                                                                                \
  {                                                                                                                     \
    {                                                                                                                   \
      const int pp_ = tid >> 5, k_ = tid & 31;                                                                          \
      *(f32x2*)(REC + pp_ * 768 + 192 + 2 * k_) = (f32x2){__uint_as_float((unsigned)NX[0]), __uint_as_float((unsigned)(NX[0] >> 32))}; \
      const unsigned lo_ = (unsigned)NX[5], hi_ = (unsigned)(NX[5] >> 32);                                              \
      *(f32x4*)(REC + pp_ * 768 + 576 + 4 * k_) = (f32x4){bf_lo(lo_), bf_hi(lo_), bf_lo(hi_), bf_hi(hi_)};              \
    }                                                                                                                   \
    _Pragma("unroll") for (int n = 0; n < 4; ++n) {                                                                     \
      const int idx_ = n * 256 + tid, pp_ = idx_ >> 7, vec_ = (idx_ >> 4) & 7, k_ = idx_ & 15;                          \
      const unsigned lo_ = (unsigned)NX[1 + n], hi_ = (unsigned)(NX[1 + n] >> 32);                                      \
      *(f32x4*)(REC + pp_ * 768 + rec_voff(vec_) + 4 * k_) = (f32x4){bf_lo(lo_), bf_hi(lo_), bf_lo(hi_), bf_hi(hi_)};   \
    }                                                                                                                   \
    if (tid < 16) *(f32x2*)(REC + (tid >> 1) * 768 + 704 + 2 * (tid & 1)) = (f32x2){__uint_as_float((unsigned)NX[6]), __uint_as_float((unsigned)(NX[6] >> 32))}; \
  }
  if (tid == 0) PC_WAIT(flag_ld(FLAG_PROD(chain, 0)) < 1u);
  __syncthreads();
  CONS_ISSUE(nxA, 0)
  CONS_INSTALL(nxA)
  if (tid == 0) PC_WAIT(flag_ld(FLAG_PROD(chain, 1 % NPROD)) < 2u);
  __syncthreads();
  CONS_ISSUE(nxA, 1)
  unsigned fnext = 0u;
  if (tid == 0) fnext = flag_ld(FLAG_PROD(chain, 2 % NPROD));
#define CONS_FETCH(PP, BUF)                                                                                             \
  {                                                                                                                     \
    const float* Rb_ = REC + (PP) * 768;                                                                                \
    _Pragma("unroll") for (int f = 0; f < 9; ++f) L[BUF][f] = *(const f32x4*)(Rb_ + f * 64 + 4 * g);                    \
    vv[BUF] = *(const f32x2*)(Rb_ + 576 + (split * RPB + rowb0) * 2);                                                   \
    sc[BUF] = *(const f32x4*)(Rb_ + 704);                                                                               \
  }
#define CONS_ITER(CH, NXC, NXN)                                                                                         \
  {                                                                                                                     \
    const int ch = (CH);                                                                                                \
      \
    if (tid == 0 && ch + 3 < 272) fnext = flag_ld(FLAG_PROD(chain, (ch + 3) % NPROD));                                  \
    if (ch + 2 < 272) CONS_ISSUE(NXN, ch + 2)    \
    {                                                                                                                   \
      f32x4 L[2][9]; f32x2 vv[2]; f32x4 sc[2];                                                                          \
      CONS_FETCH(0, 0)                                                                                                  \
      _Pragma("unroll") for (int pp = 0; pp < 8; ++pp) {                                                                \
        const int cbf = pp & 1;                                                                                         \
        if (pp < 7) CONS_FETCH(pp + 1, cbf ^ 1)                                                                         \
        const f32x4 KA = L[cbf][0], P1 = L[cbf][1], P2 = L[cbf][2], W2 = L[cbf][3], B1 = L[cbf][4], K1 = L[cbf][5];     \
        const f32x4 BB = L[cbf][6], KBv = L[cbf][7], RB = L[cbf][8];                                                    \
        const float va = vv[cbf][0], vb = vv[cbf][1];                                                                   \
        f32x2 e1 = S0 * KA.xy; e1 += S1 * KA.zw;                                                                        \
        f32x2 e2 = S0 * P1.xy; e2 += S1 * P1.zw;                                                                        \
        f32x2 e3 = S0 * P2.xy; e3 += S1 * P2.zw;                                                                        \
        float sa_a = e1[0] + e1[1], raw2 = e2[0] + e2[1];                                                               \
        const float d3 = e3[0] + e3[1];                                                                                 \
        red16x2(sa_a, raw2);                                                                                            \
        const f32x2 va2 = {va, va}, vb2 = {vb, vb}, saa2 = {sa_a, sa_a};                                                \
        f32x2 pre0 = S0 * W2.xy + (va2 * K1.xy - saa2 * B1.xy) + vb2 * KBv.xy;                                          \
        f32x2 pre1 = S1 * W2.zw + (va2 * K1.zw - saa2 * B1.zw) + vb2 * KBv.zw;                                          \
        const float sa_b = raw2 - sa_a * sc[cbf][0] + va * sc[cbf][1];                                                  \
        const f32x2 sab2 = {sa_b, sa_b};                                                                                \
        S0 = pre0 - sab2 * BB.xy;                                                                                       \
        S1 = pre1 - sab2 * BB.zw;                                                                                       \
        const float fix = (g == 0) ? (va * sc[cbf][3] - sa_a * sc[cbf][2]) : 0.f;                                       \
        f32x2 yb2 = S0 * RB.xy; yb2 += S1 * RB.zw;                                                                      \
        YB[(2 * pp) * YPT + rowb0 * LPR + g] = d3 + fix;                                                                \
        YB[(2 * pp + 1) * YPT + rowb0 * LPR + g] = yb2[0] + yb2[1];                                                     \
      }                                                                                                                 \
    }                                                                                                                   \
    __syncthreads();                                                                                                    \
    {                                                                                                                   \
      const float* yp = YB + t1 * YPT + q * LPR;                                                                        \
      float a = 0.f;                                                                                                    \
      _Pragma("unroll") for (int k4 = 0; k4 < LPR / 4; ++k4) { const f32x4 v = *(const f32x4*)(yp + 4 * k4); a += (v[0] + v[1]) + (v[2] + v[3]); } \
      const unsigned orow = (unsigned)(d * MROWS + b * TT + scan_tok(ch * 16 + t1, d));                                 \
      YR[(size_t)orow * 512 + h * 64 + split * RPB + q] = bf1(a);                                                       \
    }                                                                                                                   \
    if (ch + 1 < 272) CONS_INSTALL(NXC)                                                                                 \
    if (tid == 0 && ch + 3 < 272 && fnext < (unsigned)(ch + 4)) PC_WAIT(flag_ld(FLAG_PROD(chain, (ch + 3) % NPROD)) < (unsigned)(ch + 4)); \
    __syncthreads();                                                                                                    \
    if (ch + 1 < 272 && tid == 0) flag_st(FLAG_CONS(chain, split), (unsigned)(ch + 2));     \
  }
  if (tid == 0 && fnext < 3u) PC_WAIT(flag_ld(FLAG_PROD(chain, 2 % NPROD)) < 3u);
  __syncthreads();
  for (int c2i = 0; c2i < 272; c2i += 2) {
    CONS_ITER(c2i, nxA, nxB)
    CONS_ITER(c2i + 1, nxB, nxA)
  }
#undef CONS_ISSUE
#undef CONS_INSTALL
#undef CONS_FETCH
#undef CONS_ITER
  __builtin_amdgcn_s_setprio(0);
}

DI void phase_mixer0(const Params& p, char* smem, int vb, int nvb) {
  constexpr int NROLE = 256 + 64 * NPROD;
  __shared__ int s_item;
  if (vb < 256) scan_consumer(p, smem, vb & 63, vb >> 6);
  else if (vb < NROLE) scan_producer(p, smem, (vb - 256) & 63, (vb - 256) >> 6);
  unsigned* ctr = (unsigned*)(p.ws + OFF_FLAGS) + 385 * 64;
  for (;;) {
    __syncthreads();
    if (threadIdx.x == 0) s_item = (int)__hip_atomic_fetch_add(ctr, 1u, __ATOMIC_RELAXED, __HIP_MEMORY_SCOPE_AGENT);
    __syncthreads();
    const int it = s_item;
    if (it >= 1088) break;
    if (it < 1024) {
      const int b = it >> 8, head = (it >> 5) & 7, qb = it & 31;
      attn_block(p, smem, 512, 2, b, head, qb * 128, 0, 68, 0, 0, false, false, 0.f);
    } else {
      const int j = it - 1024;
      const int b = j >> 4, head = (j >> 1) & 7, qb = j & 1;
      attn_block(p, smem, 512, 2, b, head, 4096 + qb * 128, 64, 4, 0, 0, false, false, 0.f);
    }
  }
}

DI void phase_combine(const Params& p, int vb, int nvb) {
  const u16* YR = (const u16*)(p.ws + OFF_OB);
  const u16* VSH = (const u16*)(p.ws + OFF_VSH);
  const float* BONS = (const float*)(p.ws + OFF_BONS);
  const u16* G = (const u16*)(p.ws + OFF_G);
  u16* A2 = (u16*)(p.ws + OFF_HX);
  const int q = threadIdx.x & 15, pi = threadIdx.x >> 4;
  for (int u = vb; u < MROWS * 8 / 16; u += nvb) {
    const int pair = u * 16 + pi;
    const size_t row = (size_t)(pair >> 3); const int h = pair & 7;
    const int col = h * 64 + 4 * q;
    const f32x4 gnw = *(const f32x4*)(p.gn_w_b + col), gnb = *(const f32x4*)(p.gn_b_b + col);
    const u32x2 vu = *(const u32x2*)(VSH + row * 512 + col);
    const float v0 = bf_lo(vu.x), v1 = bf_hi(vu.x), v2 = bf_lo(vu.y), v3 = bf_hi(vu.y);
    float a0 = 0.f, a1 = 0.f, a2 = 0.f, a3 = 0.f;
#pragma unroll
    for (int d = 0; d < 2; ++d) {
      const u32x2 yu = *(const u32x2*)(YR + ((size_t)d * MROWS + row) * 512 + col);
      const float y0 = bf_lo(yu.x), y1 = bf_hi(yu.x), y2 = bf_lo(yu.y), y3 = bf_hi(yu.y);
      const float mean = reduce16((y0 + y1) + (y2 + y3)) * (1.f / 64.f);
      const float d0 = y0 - mean, d1 = y1 - mean, d2 = y2 - mean, d3 = y3 - mean;
      const float var = reduce16(d0 * d0 + d1 * d1 + d2 * d2 + d3 * d3) * (1.f / 64.f);
      const float rstd = rsqrtf(var + 64e-5f);
      const float bon = BONS[((size_t)d * MROWS + row) * 8 + h];
      a0 += d0 * rstd * gnw[0] + gnb[0] + bon * v0; a1 += d1 * rstd * gnw[1] + gnb[1] + bon * v1;
      a2 += d2 * rstd * gnw[2] + gnb[2] + bon * v2; a3 += d3 * rstd * gnw[3] + gnb[3] + bon * v3;
    }
    const u32x2 gq = *(const u32x2*)(G + row * 1024 + 512 + col);
    *(u32x2*)(A2 + row * 1024 + 512 + col) = mk2(pk2(a0 * bf_lo(gq.x), a1 * bf_hi(gq.x)), pk2(a2 * bf_lo(gq.y), a3 * bf_hi(gq.y)));
  }
}

DI void phase_post(const Params& p, int vb, int nvb) {
  const int tid = threadIdx.x, lane = tid & 63, w = tid >> 6;
  const float* MOD = (const float*)(p.ws + OFF_MOD);
  const u16* Y = (const u16*)(p.ws + OFF_Y);
  u16* HX = (u16*)(p.ws + OFF_HX);
  for (int u = vb; u < MROWS / 4; u += nvb) {
    const int rowg = u * 4 + w;
    const int b = rowg / TT, tok = rowg - b * TT;
    const bool lat = tok < 4096;
    const float* src = lat ? p.x + ((size_t)b * 4096 + tok) * 1024 : p.ctx + ((size_t)b * 256 + (tok - 4096)) * 1024;
    const float* mod0 = MOD + (0 * 5 + (lat ? b : 4)) * 3072;
    const float* mod1 = MOD + (1 * 5 + (lat ? b : 4)) * 3072;
    f32x4 yv[4]; float ss = 0.f;
#pragma unroll
    for (int j = 0; j < 4; ++j) { const u32x2 yu = *(const u32x2*)(Y + (size_t)rowg * 1024 + j * 256 + lane * 4); yv[j] = (f32x4){bf_lo(yu.x), bf_hi(yu.x), bf_lo(yu.y), bf_hi(yu.y)}; ss += yv[j][0] * yv[j][0] + yv[j][1] * yv[j][1] + yv[j][2] * yv[j][2] + yv[j][3] * yv[j][3]; }
    ss = wave_sum(ss);
    const float rinv = rsqrtf(ss * (1.f / 1024.f) + 1e-6f);
    f32x4 x1[4]; float s1 = 0.f;
#pragma unroll
    for (int j = 0; j < 4; ++j) {
      const int col = j * 256 + lane * 4;
      const f32x4 xv = __builtin_nontemporal_load((const f32x4*)(src + col)), gp = *(const f32x4*)(p.g_post + col), gt = *(const f32x4*)(mod0 + 2048 + col);
#pragma unroll
      for (int e = 0; e < 4; ++e) { x1[j][e] = xv[e] + gt[e] * (yv[j][e] * rinv * gp[e]); s1 += x1[j][e] * x1[j][e]; }
      if (lat) *(u32x2*)((u16*)(p.ws + OFF_OB) + ((size_t)b * 4096 + tok) * 1024 + col) = mk2(pk2(x1[j][0], x1[j][1]), pk2(x1[j][2], x1[j][3]));
    }
    s1 = wave_sum(s1);
    const float rinv1 = rsqrtf(s1 * (1.f / 1024.f) + 1e-6f);
#pragma unroll
    for (int j = 0; j < 4; ++j) {
      const int col = j * 256 + lane * 4;
      const f32x4 g = *(const f32x4*)(p.g_pre + 1024 + col), sh = *(const f32x4*)(mod1 + col), scv = *(const f32x4*)(mod1 + 1024 + col);
      float hv[4];
#pragma unroll
      for (int e = 0; e < 4; ++e) hv[e] = (x1[j][e] * rinv1 * g[e]) * (1.f + scv[e]) + sh[e];
      *(u32x2*)(HX + (size_t)rowg * 1024 + col) = mk2(pk2(hv[0], hv[1]), pk2(hv[2], hv[3]));
    }
  }
}

DI void phase_attn1(const Params& p, char* smem, int vb, int nvb) {
  for (int it = vb; it < 2048; it += nvb) {
    const int b = it >> 9, head = (it >> 5) & 15, qb = it & 31;
    const int q0 = qb * 128;
    const int lo = (q0 - 128 < 0) ? 0 : q0 - 128, hi = (q0 + 256 > 4096) ? 4096 : q0 + 256;
    attn_block(p, smem, 1024, 4, b, head, q0, 64, 4, lo >> 6, (hi - lo) >> 6, true, true, p.sink_c[head] * 1.4426950408889634f);
  }
}

DI void phase_final(const Params& p, int vb, int nvb) {
  const int tid = threadIdx.x, lane = tid & 63, w = tid >> 6;
  const float* MOD = (const float*)(p.ws + OFF_MOD);
  const u16* Y = (const u16*)(p.ws + OFF_Y);
  for (int u = vb; u < 4096; u += nvb) {
    const int rowl = u * 4 + w;
    const int b = rowl >> 12, tok = rowl & 4095;
    const size_t rowg = (size_t)b * TT + tok;
    const float* mod1 = MOD + (1 * 5 + b) * 3072;
    f32x4 yv[4]; float ss = 0.f;
#pragma unroll
    for (int j = 0; j < 4; ++j) { const u32x2 yu = *(const u32x2*)(Y + rowg * 1024 + j * 256 + lane * 4); yv[j] = (f32x4){bf_lo(yu.x), bf_hi(yu.x), bf_lo(yu.y), bf_hi(yu.y)}; ss += yv[j][0] * yv[j][0] + yv[j][1] * yv[j][1] + yv[j][2] * yv[j][2] + yv[j][3] * yv[j][3]; }
    ss = wave_sum(ss);
    const float rinv = rsqrtf(ss * (1.f / 1024.f) + 1e-6f);
#pragma unroll
    for (int j = 0; j < 4; ++j) {
      const int col = j * 256 + lane * 4;
      float* op = p.out + (size_t)rowl * 1024 + col;
      const u32x2 xu = *(const u32x2*)((const u16*)(p.ws + OFF_OB) + (size_t)rowl * 1024 + col);
      const f32x4 xv = {bf_lo(xu.x), bf_hi(xu.x), bf_lo(xu.y), bf_hi(xu.y)}, gp = *(const f32x4*)(p.g_post + 1024 + col), gt = *(const f32x4*)(mod1 + 2048 + col);
      f32x4 ov;
#pragma unroll
      for (int e = 0; e < 4; ++e) ov[e] = xv[e] + gt[e] * (yv[j][e] * rinv * gp[e]);
      __builtin_nontemporal_store(ov, (f32x4*)op);
    }
  }
}

#ifndef PHMASK
#define PHMASK 0x7ff
#endif
#ifndef LB2
#define LB2 2
#endif
#define PH_ON(i) (((PHMASK) >> (i)) & 1)
static constexpr int SMEM_BYTES = 73728;
__global__ void __launch_bounds__(256, LB2) hybrid_fwd(Params p) {
  extern __shared__ __attribute__((aligned(16))) char smem[];
  __shared__ u32x4 xb_words;
  cg::grid_group grid = cg::this_grid();
  const int vb = blockIdx.x, nvb = gridDim.x;
  XcdBarrier xb; xb.bar = (unsigned*)(p.ws + OFF_BAR); xb.x = 0; xb.st = (volatile LAS unsigned*)&xb_words;
  if (p.ph_hi - p.ph_lo > 1) {
    if (threadIdx.x == 0) xb_words = (u32x4){0u, 0u, 0u, 0u};
    __syncthreads();
    xb = xcd_barrier_post((unsigned*)(p.ws + OFF_BAR), (volatile LAS unsigned*)&xb_words);
  }
#ifndef DUP_PH
#define DUP_PH -1
#endif
#define RUN_PH(i, call)                                            \
  if (PH_ON(i) && p.ph_lo <= (i) && (i) < p.ph_hi) { call; if ((i) == DUP_PH) { __syncthreads(); call; } }         \
  if (p.ph_lo <= (i) && (i) + 1 < p.ph_hi) { if (p.ph_hi > 1000) grid.sync(); else xcd_barrier(xb); }
#ifdef EXTRA_SYNC
  for (int es = 0; es < EXTRA_SYNC; ++es) grid.sync();
#endif
  RUN_PH(0, phase_prep(p, smem, vb, nvb))
  int vid = vb;
  if (p.ph_hi - p.ph_lo > 1) {
    if (threadIdx.x == 0) {
      unsigned base = 0u;
#pragma unroll
      for (unsigned j = 0; j < 16; ++j) { const unsigned c = xb_ld(&xb.bar[XB_XCNT(j)]); base += (j < xb.x) ? c : 0u; }
      xb.st[3] = base + xb.st[2];
    }
    __syncthreads();
    vid = (int)xb.st[3];
  }
  RUN_PH(1, phase_prenorm0(p, vb, nvb))
  RUN_PH(2, gemm_phase<0>(p, smem, vb, nvb, (const u16*)(p.ws + OFF_WT0), (const u16*)(p.ws + OFF_HX), 28))
  RUN_PH(3, phase_mixer0(p, smem, vb, nvb))
  RUN_PH(4, phase_combine(p, vb, nvb))
  RUN_PH(5, gemm_phase<1>(p, smem, vb, nvb, (const u16*)(p.ws + OFF_WT1), (const u16*)(p.ws + OFF_HX), 8))
  RUN_PH(6, phase_post(p, vb, nvb))
  RUN_PH(7, gemm_phase<2>(p, smem, vb, nvb, (const u16*)(p.ws + OFF_WT2), (const u16*)(p.ws + OFF_HX), 20))
  RUN_PH(8, phase_attn1(p, smem, vb, nvb))
  RUN_PH(9, gemm_phase<3>(p, smem, vb, nvb, (const u16*)(p.ws + OFF_WT3), (const u16*)(p.ws + OFF_HX), 8))
  RUN_PH(10, phase_final(p, vb, nvb))
#undef RUN_PH
}

extern "C" void kernel_launch(void* const* d_in, const int* in_sizes, int n_in, void* d_out, int out_size, void* d_ws, size_t ws_size, hipStream_t stream) {
  static int grid_blocks = 0;
  if (grid_blocks == 0) {
    if (n_in != 27 || ws_size < WS_END) { fprintf(stderr, "kernel_launch: expected 27 inputs and >= %zu bytes of workspace (got %d, %zu)\n", (size_t)WS_END, n_in, ws_size); grid_blocks = -1; return; }
    int dev = 0, cus = 0, per_cu = 0;
    hipGetDevice(&dev);
    hipDeviceGetAttribute(&cus, hipDeviceAttributeMultiprocessorCount, dev);
    hipFuncSetAttribute((const void*)hybrid_fwd, hipFuncAttributeMaxDynamicSharedMemorySize, SMEM_BYTES);
    hipOccupancyMaxActiveBlocksPerMultiprocessor(&per_cu, hybrid_fwd, 256, SMEM_BYTES);
    if (per_cu < 1) per_cu = 1;
    if (per_cu > 2) per_cu = 2;
    grid_blocks = cus * per_cu;
    if (grid_blocks < 512) { fprintf(stderr, "kernel_launch: needs 512 co-resident blocks, got %d\n", grid_blocks); grid_blocks = -1; return; }
    grid_blocks = 512;
    fprintf(stderr, "kernel_launch: cus %d per_cu %d grid %d\n", cus, per_cu, grid_blocks);
  }
  if (grid_blocks < 0) return;
  Params p;
  memset(&p, 0, sizeof(p));
  const float** pp = (const float**)&p;
  for (int i = 0; i < 27; ++i) pp[i] = (const float*)d_in[i];
  p.out = (float*)d_out;
  p.ws = (unsigned char*)d_ws;
#if N_LAUNCH_MODE == 1
  p.ph_lo = 0; p.ph_hi = NPH;
  hipMemsetAsync((unsigned char*)d_ws + OFF_BAR, 0, 16384 + 131072, stream);
  void* args[] = {&p};
  hipError_t e = hipLaunchCooperativeKernel((void*)hybrid_fwd, dim3(grid_blocks), dim3(256), args, SMEM_BYTES, stream);
  if (e != hipSuccess) fprintf(stderr, "cooperative launch failed: %s (grid %d)\n", hipGetErrorString(e), grid_blocks);
#else
  for (int ph = 0; ph < NPH; ++ph) {
    p.ph_lo = ph; p.ph_hi = ph + 1;
    hipLaunchKernelGGL(hybrid_fwd, dim3(grid_blocks), dim3(256), SMEM_BYTES, stream, p);
  }
#endif
}
```
